# Optimizing an MI355X kernel written in HIP

```python
import functools
import math
import jax
import jax.numpy as jnp
from jax import lax
import numpy as np

D_MODEL = 1024
BATCH = 2
SEQ = 8192
DEPTH = 2

GRID_W = 64
CTX_LEN = 256
ROPE_THETA = 10000.0
NORM_EPS = 1e-6
NEG_INF = -1e30
BLOCK = 128
WINDOW = 128

A_HEADS = 8
A_KV_HEADS = 2
A_HEAD_DIM = 64
B_HEADS = 4
B_QK_DIM = 64
B_V_DIM = 2 * B_QK_DIM
A_Q_W = A_HEADS * A_HEAD_DIM
A_KV_W = A_KV_HEADS * A_HEAD_DIM
B_QK_W = B_HEADS * 2 * B_QK_DIM
B_V_W = B_HEADS * B_V_DIM
AB_Q_W = A_Q_W + B_QK_W
AB_IN_W = AB_Q_W + 2 * A_KV_W + B_QK_W + B_V_W
AB_OUT_W = A_Q_W + B_V_W

C_HEADS = 16
C_Q_LORA = 384
C_KV_LORA = 256
C_NOPE = 64
C_ROPE = 32
C_V = 64
C_IN_W = C_Q_LORA + C_KV_LORA + C_ROPE
C_OUT_W = C_HEADS * C_V

FFN_HIDDEN = ((8 * D_MODEL + 3 * 256 - 1) // (3 * 256)) * 256

N_EVEN = (DEPTH + 1) // 2
N_ODD = DEPTH // 2

F32 = jnp.float32

kernel_name = 'hybrid_dit_swa_diff_mla_prefix'


def rmsnorm(x, g):
    xf = x.astype(F32)
    y = xf * lax.rsqrt(jnp.mean(xf * xf, axis=-1, keepdims=True) + NORM_EPS)
    return (y * g.astype(F32)).astype(x.dtype)


def modulate(xn, shift, scale):
    return xn * (1.0 + scale) + shift


def joint_softmax(*logits):
    m = functools.reduce(jnp.maximum, [s.max(axis=-1, keepdims=True) for s in logits])
    e = [jnp.exp(s - m) for s in logits]
    inv = 1.0 / functools.reduce(jnp.add, [t.sum(axis=-1, keepdims=True) for t in e])
    return [t * inv for t in e]


def axial_rope_tables(rows, rot_dim):
    row = jnp.repeat(jnp.arange(rows, dtype=F32), GRID_W)
    col = jnp.tile(jnp.arange(GRID_W, dtype=F32), rows)
    axis_dim = rot_dim // 2
    inv_freq = ROPE_THETA ** (-jnp.arange(0, axis_dim, 2, dtype=F32) / axis_dim)
    ang = jnp.concatenate([row[:, None] * inv_freq, col[:, None] * inv_freq], axis=-1)
    return jnp.cos(ang), jnp.sin(ang)


def apply_axial_rope(x, tab):
    cos, sin = tab
    quarter = x.shape[-1] // 4
    xr, xc = jnp.split(x.astype(F32), 2, axis=-1)

    def rot(u, cs, sn):
        u1, u2 = jnp.split(u, 2, axis=-1)
        return jnp.concatenate([u1 * cs - u2 * sn, u2 * cs + u1 * sn], axis=-1)

    out = jnp.concatenate([
        rot(xr, cos[:, None, :quarter], sin[:, None, :quarter]),
        rot(xc, cos[:, None, quarter:], sin[:, None, quarter:])], axis=-1)
    return out.astype(x.dtype)


def to_blocks(t):
    b, n = t.shape[:2]
    return jnp.moveaxis(t.reshape(b, n // BLOCK, BLOCK, *t.shape[2:]), 1, 0)


def from_blocks(t):
    t = jnp.moveaxis(t, 0, 1)
    return t.reshape(t.shape[0], -1, *t.shape[3:])


def swiglu(h, w13, w2):
    gate, up = jnp.split(h @ w13, 2, axis=-1)
    return (jax.nn.silu(gate) * up) @ w2


def lambda_init(layer_idx):
    return 0.8 - 0.6 * math.exp(-0.3 * layer_idx)


def window_gqa_latent(q, k, v, k_ctx, v_ctx, sink):
    bsz, n, _, dh = q.shape
    nb = n // BLOCK
    g = A_HEADS // A_KV_HEADS
    scale = dh ** -0.5
    qb = q.reshape(bsz, nb, BLOCK, A_KV_HEADS, g, dh)

    def band(t):
        tp = jnp.pad(t, ((0, 0), (BLOCK, BLOCK), (0, 0), (0, 0)))
        tp = tp.reshape(bsz, nb + 2, BLOCK, A_KV_HEADS, dh)
        return jnp.concatenate([tp[:, :-2], tp[:, 1:-1], tp[:, 2:]], axis=2)

    kb, vb = band(k), band(v)
    s_loc = jnp.einsum('bnqhgd,bnkhd->bhgnqk', qb, kb).astype(F32) * scale
    s_ctx = jnp.einsum('bnqhgd,bchd->bhgnqc', qb, k_ctx).astype(F32) * scale
    qi = jnp.arange(BLOCK)[:, None]
    kj = jnp.arange(3 * BLOCK)[None, :]
    key_pos = (jnp.arange(nb)[:, None, None] - 1) * BLOCK + kj[None]
    valid = (jnp.abs(kj - BLOCK - qi) <= WINDOW)[None] & (key_pos >= 0) & (key_pos < n)
    s_loc = jnp.where(valid, s_loc, NEG_INF)
    s_sink = sink.astype(F32).reshape(1, A_KV_HEADS, g, 1, 1, 1)
    p_loc, p_ctx, _ = joint_softmax(s_loc, s_ctx, s_sink)
    o = (jnp.einsum('bhgnqk,bnkhd->bnqhgd', p_loc.astype(v.dtype), vb)
         + jnp.einsum('bhgnqc,bchd->bnqhgd', p_ctx.astype(v.dtype), v_ctx))
    return o.reshape(bsz, n, A_HEADS * dh)


def gqa_ctx(q, k, v, sink):
    bsz, t, _, dh = q.shape
    g = A_HEADS // A_KV_HEADS
    qg = q.reshape(bsz, t, A_KV_HEADS, g, dh)
    s = jnp.einsum('bqhgd,bkhd->bhgqk', qg, k).astype(F32) * dh ** -0.5
    p, _ = joint_softmax(s, sink.astype(F32).reshape(1, A_KV_HEADS, g, 1, 1))
    o = jnp.einsum('bhgqk,bkhd->bqhgd', p.astype(v.dtype), v)
    return o.reshape(bsz, t, A_HEADS * dh)


def diff_attend(q, kv_parts, lam):
    scale = q.shape[-1] ** -0.5
    logits = [jnp.einsum('bqhmd,bkhmd->bmhqk', q, k).astype(F32) * scale for k, _ in kv_parts]
    probs = joint_softmax(*logits)
    outs = [jnp.einsum('bhqk,bkhd->bqhd', (p[:, 0] - lam * p[:, 1]).astype(v.dtype), v)
            for p, (_, v) in zip(probs, kv_parts)]
    return functools.reduce(jnp.add, outs)


def diff_out(o, subln_g, lam_init):
    b, t = o.shape[:2]
    return (rmsnorm(o, subln_g) * (1.0 - lam_init)).reshape(b, t, -1)


def ab_queries(p_q):
    b, t = p_q.shape[:2]
    qa = p_q[..., :A_Q_W].reshape(b, t, A_HEADS, A_HEAD_DIM)
    qb = p_q[..., A_Q_W:].reshape(b, t, B_HEADS, 2, B_QK_DIM)
    return qa, qb


def ab_keys_values(p_kv):
    b, t = p_kv.shape[:2]
    o1 = A_KV_W
    o2 = 2 * A_KV_W
    o3 = o2 + B_QK_W
    ka = p_kv[..., :o1].reshape(b, t, A_KV_HEADS, A_HEAD_DIM)
    va = p_kv[..., o1:o2].reshape(b, t, A_KV_HEADS, A_HEAD_DIM)
    kb = p_kv[..., o2:o3].reshape(b, t, B_HEADS, 2, B_QK_DIM)
    vb = p_kv[..., o3:].reshape(b, t, B_HEADS, B_V_DIM)
    return ka, va, kb, vb


def rope_diff(t, tab):
    b, n = t.shape[:2]
    return apply_axial_rope(t.reshape(b, n, B_HEADS * 2, B_QK_DIM), tab).reshape(t.shape)


def mixer_ab(hx, hc, w_in, w_out, sink, lam_vec, subln_g, lam_init, tab, ctx_queries):
    p = hx @ w_in
    qa, qb = ab_queries(p[..., :AB_Q_W])
    ka, va, kb, vb = ab_keys_values(p[..., AB_Q_W:])
    qa, ka = apply_axial_rope(qa, tab), apply_axial_rope(ka, tab)
    qb, kb = rope_diff(qb, tab), rope_diff(kb, tab)
    if ctx_queries:
        pc = hc @ w_in
        cqa, cqb = ab_queries(pc[..., :AB_Q_W])
        cka, cva, ckb, cvb = ab_keys_values(pc[..., AB_Q_W:])
    else:
        cka, cva, ckb, cvb = ab_keys_values(hc @ w_in[:, AB_Q_W:])
    lv = lam_vec.astype(F32)
    lam = jnp.exp(jnp.sum(lv[0] * lv[1])) - jnp.exp(jnp.sum(lv[2] * lv[3])) + lam_init

    oa = window_gqa_latent(qa, ka, va, cka, cva, sink)
    ob = from_blocks(lax.map(lambda qblk: diff_attend(qblk, [(kb, vb), (ckb, cvb)], lam),
                             to_blocks(qb)))
    yx = jnp.concatenate([oa, diff_out(ob, subln_g, lam_init)], axis=-1) @ w_out
    if not ctx_queries:
        return yx, None
    oca = gqa_ctx(cqa, cka, cva, sink)
    ocb = diff_out(diff_attend(cqb, [(ckb, cvb)], lam), subln_g, lam_init)
    yc = jnp.concatenate([oca, ocb], axis=-1) @ w_out
    return yx, yc


def mla_queries(p_q, q_norm_g, wq_b):
    b, t = p_q.shape[:2]
    q = (rmsnorm(p_q, q_norm_g) @ wq_b).reshape(b, t, C_HEADS, C_NOPE + C_ROPE)
    return q[..., :C_NOPE], q[..., C_NOPE:]


def mla_keys_values(p_kv, kv_norm_g, wkv_b):
    b, t = p_kv.shape[:2]
    kv_lat, k_rope = p_kv[..., :C_KV_LORA], p_kv[..., C_KV_LORA:]
    kv = (rmsnorm(kv_lat, kv_norm_g) @ wkv_b).reshape(b, t, C_HEADS, C_NOPE + C_V)
    return kv[..., :C_NOPE], k_rope, kv[..., C_NOPE:]


def mla_attend(q_nope, q_rope, kv_parts):
    scale = (C_NOPE + C_ROPE) ** -0.5
    logits = [(jnp.einsum('bqhd,bkhd->bhqk', q_nope, kn)
               + jnp.einsum('bqhr,bkr->bhqk', q_rope, kr)).astype(F32) * scale
              for kn, kr, _ in kv_parts]
    probs = joint_softmax(*logits)
    outs = [jnp.einsum('bhqk,bkhd->bqhd', p.astype(v.dtype), v) for p, (_, _, v) in zip(probs, kv_parts)]
    return functools.reduce(jnp.add, outs)


def mixer_mla(hx, hc, w_in, q_norm_g, kv_norm_g, wq_b, wkv_b, w_out, tab, ctx_queries):
    bsz, n, _ = hx.shape
    p = hx @ w_in
    qn, qr = mla_queries(p[..., :C_Q_LORA], q_norm_g, wq_b)
    kn, kr, v = mla_keys_values(p[..., C_Q_LORA:], kv_norm_g, wkv_b)
    qr = apply_axial_rope(qr, tab)
    kr = apply_axial_rope(kr[:, :, None, :], tab)[:, :, 0, :]
    if ctx_queries:
        pc = hc @ w_in
        cqn, cqr = mla_queries(pc[..., :C_Q_LORA], q_norm_g, wq_b)
        ckn, ckr, cv = mla_keys_values(pc[..., C_Q_LORA:], kv_norm_g, wkv_b)
    else:
        ckn, ckr, cv = mla_keys_values(hc @ w_in[:, C_Q_LORA:], kv_norm_g, wkv_b)
    o = from_blocks(lax.map(lambda qs: mla_attend(qs[0], qs[1], [(kn, kr, v), (ckn, ckr, cv)]),
                            (to_blocks(qn), to_blocks(qr))))
    yx = o.reshape(bsz, n, C_OUT_W) @ w_out
    if not ctx_queries:
        return yx, None
    oc = mla_attend(cqn, cqr, [(ckn, ckr, cv)])
    yc = oc.reshape(bsz, hc.shape[1], C_OUT_W) @ w_out
    return yx, yc


def setup_inputs(seed: int = 0) -> dict:
    key = jax.random.key(seed)
    ks = jax.random.split(key, 20)

    def nrm(k, shape, scale):
        return jax.random.normal(k, shape, F32) * scale

    d = D_MODEL
    return {
        'x': nrm(ks[0], (BATCH, SEQ, d), 1.0),
        'c': nrm(ks[1], (BATCH, d), 1.0),
        'ctx': nrm(ks[2], (BATCH, CTX_LEN, d), 1.0),
        'c_ctx': nrm(ks[3], (d,), 1.0),
        'ada_w': nrm(ks[4], (DEPTH, d, 6 * d), 0.5 * d ** -0.5),
        'ada_b': nrm(ks[5], (DEPTH, 6 * d), 0.01),
        'norm_g': 1.0 + nrm(ks[6], (DEPTH, 4, d), 0.05),
        'ffn_w13': nrm(ks[7], (DEPTH, d, 2 * FFN_HIDDEN), d ** -0.5),
        'ffn_w2': nrm(ks[8], (DEPTH, FFN_HIDDEN, d), FFN_HIDDEN ** -0.5),
        'ab_w_in': nrm(ks[9], (N_EVEN, d, AB_IN_W), d ** -0.5),
        'ab_w_out': nrm(ks[10], (N_EVEN, AB_OUT_W, d), AB_OUT_W ** -0.5),
        'ab_sink': nrm(ks[11], (N_EVEN, A_HEADS), 0.5),
        'diff_lambda': nrm(ks[12], (N_EVEN, 4, B_QK_DIM), 0.1),
        'diff_subln_g': 1.0 + nrm(ks[13], (N_EVEN, B_V_DIM), 0.05),
        'mla_w_in': nrm(ks[14], (N_ODD, d, C_IN_W), d ** -0.5),
        'mla_q_norm_g': 1.0 + nrm(ks[15], (N_ODD, C_Q_LORA), 0.05),
        'mla_kv_norm_g': 1.0 + nrm(ks[16], (N_ODD, C_KV_LORA), 0.05),
        'mla_wq_b': nrm(ks[17], (N_ODD, C_Q_LORA, C_HEADS * (C_NOPE + C_ROPE)), C_Q_LORA ** -0.5),
        'mla_wkv_b': nrm(ks[18], (N_ODD, C_KV_LORA, C_HEADS * (C_NOPE + C_V)), C_KV_LORA ** -0.5),
        'mla_w_out': nrm(ks[19], (N_ODD, C_OUT_W, d), C_OUT_W ** -0.5),
    }


def reference(x, c, ctx, c_ctx, ada_w, ada_b, norm_g, ffn_w13, ffn_w2,
              ab_w_in, ab_w_out, ab_sink, diff_lambda, diff_subln_g,
              mla_w_in, mla_q_norm_g, mla_kv_norm_g, mla_wq_b, mla_wkv_b, mla_w_out):
    bsz, n, d = x.shape
    ROWS = n // GRID_W
    tab_ab = axial_rope_tables(ROWS, A_HEAD_DIM)
    tab_c = axial_rope_tables(ROWS, C_ROPE)
    sc_x = jax.nn.silu(c)
    sc_c = jax.nn.silu(c_ctx)
    for l in range(DEPTH):
        ctx_out = l < DEPTH - 1
        mx = (sc_x @ ada_w[l] + ada_b[l]).reshape(bsz, 6, 1, d)
        mc = (sc_c @ ada_w[l] + ada_b[l]).reshape(6, d)
        hx = modulate(rmsnorm(x, norm_g[l, 0]), mx[:, 0], mx[:, 1])
        hc = modulate(rmsnorm(ctx, norm_g[l, 0]), mc[0], mc[1])
        if l % 2 == 0:
            e = l // 2
            yx, yc = mixer_ab(hx, hc, ab_w_in[e], ab_w_out[e], ab_sink[e], diff_lambda[e],
                              diff_subln_g[e], lambda_init(l), tab_ab, ctx_out)
        else:
            o = l // 2
            yx, yc = mixer_mla(hx, hc, mla_w_in[o], mla_q_norm_g[o], mla_kv_norm_g[o],
                               mla_wq_b[o], mla_wkv_b[o], mla_w_out[o], tab_c, ctx_out)
        x = x + mx[:, 2] * rmsnorm(yx, norm_g[l, 1])
        hx = modulate(rmsnorm(x, norm_g[l, 2]), mx[:, 3], mx[:, 4])
        x = x + mx[:, 5] * rmsnorm(swiglu(hx, ffn_w13[l], ffn_w2[l]), norm_g[l, 3])
        if ctx_out:
            ctx = ctx + mc[2] * rmsnorm(yc, norm_g[l, 1])
            hc = modulate(rmsnorm(ctx, norm_g[l, 2]), mc[3], mc[4])
            ctx = ctx + mc[5] * rmsnorm(swiglu(hc, ffn_w13[l], ffn_w2[l]), norm_g[l, 3])
    return x
```

```cpp
#include <hip/hip_runtime.h>
#include <hip/hip_cooperative_groups.h>
#include <cstdio>
#include <cstdint>
namespace cg = cooperative_groups;
#ifndef MK_PER_PHASE
#define MK_PER_PHASE 0
#endif
namespace pg8 {
#define PG8_LAS __attribute__((address_space(3)))
typedef unsigned short bf16_t;
typedef short bf16x8 __attribute__((ext_vector_type(8)));
typedef float f32x4 __attribute__((ext_vector_type(4)));
typedef unsigned u32x4 __attribute__((ext_vector_type(4)));
constexpr int BM = 256, BK = 64, HALF = 128, HTB = HALF * BK * 2  , STAGE_BYTES = 8 * HTB, NXCD = 8, WGM = 8;

__host__ __device__ __forceinline__ int lds_byte(int r, int c) { const int st = (r >> 4) * 2 + (c >> 5), rr = r & 15, cc = c & 31, ob = rr * 64 + cc * 2; return st * 1024 + (ob ^ (((ob >> 9) & 1) << 5)); }
__host__ __device__ __forceinline__ void stage_rc(int b, int& R, int& C) { const int st = b / 1024, sb = b % 1024, swz = sb ^ (((sb >> 9) & 1) << 5); R = (st >> 1) * 16 + swz / 64; C = (st & 1) * 32 + (swz % 64) / 2; }
__host__ __device__ __forceinline__ int perm32(int rho) { const int n = rho >> 4, i = rho & 15; return 8 * (i >> 2) + 4 * n + (i & 3); }

struct Unit { int pm, pn; };
struct Gemm { const bf16_t* A; const bf16_t* Bt; int M, N, K, lda; };

struct StaticOrder {
    int nM, nN, nwg, G, c;
    __host__ __device__ void init(int M, int N, int G_, int c_) { nM = M / BM; nN = N / BM; nwg = nM * nN; G = G_; c = c_; }
    __host__ __device__ bool next(int i, Unit& u) const {
        const long L = (long)i * G + c; if (L >= nwg) return false;
        int wgid = (int)L; { const int q = nwg / NXCD, r = nwg % NXCD, xcd = wgid % NXCD, off = wgid / NXCD; wgid = (xcd < r ? xcd * (q + 1) : r * (q + 1) + (xcd - r) * q) + off; }
        const int nig = WGM * nN, gid = wgid / nig, fm = gid * WGM, gsz = (nM - fm) < WGM ? (nM - fm) : WGM;
        u.pm = fm + ((wgid % nig) % gsz); u.pn = (wgid % nig) / gsz; return true;
    }
    __device__ __forceinline__ void a_ready(const Unit&) const {}
    __device__ __forceinline__ void done(const Unit&) const {}
};


__device__ __forceinline__ unsigned cvt_pk_bf16(float lo, float hi) { unsigned r; asm volatile("v_cvt_pk_bf16_f32 %0, %1, %2" : "=v"(r) : "v"(lo), "v"(hi)); return r; }
typedef float f32x2 __attribute__((ext_vector_type(2)));

template <class Epi, class Sched, bool ALIGN_EPI = false, bool SP2 = false>
__device__ __forceinline__ void gemm_phase(PG8_LAS unsigned char* lds, const Gemm g, const Sched& S, const Epi& E) {
    int tid_ = threadIdx.x; asm volatile("" : "+v"(tid_));
    const int tid = tid_, wid = __builtin_amdgcn_readfirstlane(tid >> 6), lane = tid & 63, wr = wid >> 2, wc = wid & 3, fr = lane & 15, fq = lane >> 4;
    const int K = g.K, nt = K / BK;
    unsigned voffA[2], voffB[2];
#pragma unroll
    for (int i = 0; i < 2; ++i) { int R, C; stage_rc(tid * 16 + i * 8192, R, C); const int Rb = Epi::PERM ? ((R & ~31) + perm32(R & 31)) : R;
        voffA[i] = (unsigned)(R * g.lda + C) * 2u; voffB[i] = (unsigned)(Rb * K + C) * 2u; }
    const size_t kstep = (size_t)(BK * 2);
    const size_t hstep = (size_t)HALF * K * 2;
    const size_t tstep = 2 * hstep; const size_t hstepA = (size_t)HALF * g.lda * 2, tstepA = 2 * hstepA;
    const unsigned ldsw = (unsigned)wid * 1024u;
    const int aoff = lds_byte(wr * 64 + fr, fq * 8), boff = lds_byte(wc * 32 + fr, fq * 8);
#define PG8_SA(b, h) (((b) * 2 + (h)) * HTB)
#define PG8_SB(b, h) ((4 + (b) * 2 + (h)) * HTB)
#define PG8_STAGE(bufoff, gbase, voff) do { _Pragma("unroll") for (int _i = 0; _i < 2; ++_i) \
        __builtin_amdgcn_global_load_lds((const unsigned*)((const char*)(gbase) + (voff)[_i]), (PG8_LAS unsigned*)(lds + (bufoff) + ldsw + _i * 8192), 16, 0, 0); } while (0)
#define PG8_LDA(dst, b, h) do { _Pragma("unroll") for (int m = 0; m < 4; ++m) _Pragma("unroll") for (int k = 0; k < 2; ++k) dst[m][k] = *(const PG8_LAS bf16x8*)(lds + PG8_SA(b, h) + aoff + m * 2048 + k * 1024); } while (0)
#define PG8_LDB(dst, b, h) do { _Pragma("unroll") for (int n = 0; n < 2; ++n) _Pragma("unroll") for (int k = 0; k < 2; ++k) dst[n][k] = *(const PG8_LAS bf16x8*)(lds + PG8_SB(b, h) + boff + n * 2048 + k * 1024); } while (0)
#define PG8_MMA(ai, bj, At, Bt) do { __builtin_amdgcn_s_setprio(1); _Pragma("unroll") for (int m = 0; m < 4; ++m) _Pragma("unroll") for (int n = 0; n < 2; ++n) _Pragma("unroll") for (int k = 0; k < 2; ++k) \
        acc[ai][bj][m][n] = __builtin_amdgcn_mfma_f32_16x16x32_bf16(Bt[n][k], At[m][k], acc[ai][bj][m][n], 0, 0, 0); __builtin_amdgcn_s_setprio(0); } while (0)
#define PG8_WAIT_V(n) asm volatile("s_waitcnt vmcnt(" #n ")" ::: "memory")
#define PG8_WAIT_L(n) asm volatile("s_waitcnt lgkmcnt(" #n ")" ::: "memory")
#define PG8_BAR __builtin_amdgcn_s_barrier()
#define PG8_SCHED __builtin_amdgcn_sched_barrier(0)
    Unit cur, nxt; int ui = 0;
    if (!S.next(0, cur)) return;
    f32x4 acc[2][2][4][2];
#pragma unroll
    for (int a = 0; a < 2; ++a)
#pragma unroll
        for (int b = 0; b < 2; ++b)
#pragma unroll
            for (int m = 0; m < 4; ++m)
#pragma unroll
                for (int n = 0; n < 2; ++n) acc[a][b][m][n] = (f32x4){0.f, 0.f, 0.f, 0.f};
    bf16x8 At[4][2], B0[2][2], B1[2][2];
    const char* cA = (const char*)g.A + (size_t)cur.pm * tstepA; const char* cB = (const char*)g.Bt + (size_t)cur.pn * tstep;
    S.a_ready(cur);
    if constexpr (SP2) {
        PG8_STAGE(PG8_SB(0, 0), cB, voffB); PG8_STAGE(PG8_SB(0, 1), cB + hstep, voffB); PG8_STAGE(PG8_SA(0, 0), cA, voffA); PG8_STAGE(PG8_SA(0, 1), cA + hstepA, voffA);
        if (wr == 1) PG8_BAR;
        PG8_WAIT_V(2); PG8_BAR;
        PG8_STAGE(PG8_SB(1, 0), cB + kstep, voffB); PG8_STAGE(PG8_SA(1, 0), cA + kstep, voffA); PG8_STAGE(PG8_SB(1, 1), cB + hstep + kstep, voffB);
        PG8_WAIT_V(6); PG8_BAR;
    } else {
        PG8_STAGE(PG8_SB(0, 0), cB, voffB); PG8_STAGE(PG8_SA(0, 0), cA, voffA); PG8_STAGE(PG8_SB(0, 1), cB + hstep, voffB); PG8_STAGE(PG8_SA(0, 1), cA + hstepA, voffA);
        if (wr == 1) PG8_BAR;
        PG8_WAIT_V(4); PG8_BAR;
        PG8_STAGE(PG8_SB(1, 0), cB + kstep, voffB); PG8_STAGE(PG8_SA(1, 0), cA + kstep, voffA); PG8_STAGE(PG8_SB(1, 1), cB + hstep + kstep, voffB);
        PG8_WAIT_V(6); PG8_BAR;
    }
    for (;;) {
        const bool has_next = S.next(ui + 1, nxt);
        const char* nA = has_next ? (const char*)g.A + (size_t)nxt.pm * tstepA : cA; const char* nB = has_next ? (const char*)g.Bt + (size_t)nxt.pn * tstep : cB;
        for (int t = 0; t < nt; t += 2) {
            const bool last = (t == nt - 2);
            const char* a1 = cA + (size_t)(t + 1) * kstep;
            const char* a2 = last ? nA : cA + (size_t)(t + 2) * kstep; const char* b2 = last ? nB : cB + (size_t)(t + 2) * kstep;
            const char* a3 = a2 + kstep; const char* b3 = b2 + kstep;
            if (last && has_next) S.a_ready(nxt);
            if constexpr (SP2) {
            PG8_LDB(B0, 0, 0); PG8_LDB(B1, 0, 1); PG8_SCHED; PG8_LDA(At, 0, 0); PG8_STAGE(PG8_SA(1, 1), a1 + hstepA, voffA);
            PG8_WAIT_V(8); PG8_WAIT_L(0); PG8_BAR; PG8_MMA(0, 0, At, B0); PG8_MMA(0, 1, At, B1); PG8_BAR; PG8_SCHED;
            PG8_LDA(At, 0, 1); PG8_STAGE(PG8_SB(0, 0), b2, voffB); PG8_STAGE(PG8_SB(0, 1), b2 + hstep, voffB); PG8_STAGE(PG8_SA(0, 0), a2, voffA);
            PG8_WAIT_V(8); PG8_WAIT_L(0); PG8_BAR; PG8_MMA(1, 0, At, B0); PG8_MMA(1, 1, At, B1); PG8_BAR; PG8_SCHED;
            PG8_LDB(B0, 1, 0); PG8_LDB(B1, 1, 1); PG8_SCHED; PG8_LDA(At, 1, 0); PG8_STAGE(PG8_SA(0, 1), a2 + hstepA, voffA);
            PG8_WAIT_V(8); PG8_WAIT_L(0); PG8_BAR; PG8_MMA(0, 0, At, B0); PG8_MMA(0, 1, At, B1); PG8_BAR; PG8_SCHED;
            PG8_LDA(At, 1, 1); PG8_STAGE(PG8_SB(1, 0), b3, voffB); PG8_STAGE(PG8_SB(1, 1), b3 + hstep, voffB); PG8_STAGE(PG8_SA(1, 0), a3, voffA);
            PG8_WAIT_V(8); PG8_WAIT_L(0); PG8_BAR; PG8_MMA(1, 0, At, B0); PG8_MMA(1, 1, At, B1); PG8_BAR; PG8_SCHED;
            } else {
            PG8_LDB(B0, 0, 0); PG8_SCHED; PG8_LDA(At, 0, 0); PG8_STAGE(PG8_SA(1, 1), a1 + hstepA, voffA);
            PG8_WAIT_L(8); PG8_BAR; PG8_WAIT_L(0); PG8_MMA(0, 0, At, B0); PG8_BAR; PG8_SCHED;
            PG8_LDB(B1, 0, 1); PG8_STAGE(PG8_SB(0, 0), b2, voffB);
            PG8_BAR; PG8_WAIT_L(0); PG8_MMA(0, 1, At, B1); PG8_BAR;
            PG8_LDA(At, 0, 1); PG8_STAGE(PG8_SA(0, 0), a2, voffA);
            PG8_BAR; PG8_WAIT_L(0); PG8_MMA(1, 0, At, B0); PG8_BAR; PG8_SCHED;
            PG8_STAGE(PG8_SB(0, 1), b2 + hstep, voffB);
            PG8_WAIT_V(6); PG8_BAR; PG8_MMA(1, 1, At, B1); PG8_BAR;
            PG8_LDB(B0, 1, 0); PG8_SCHED; PG8_LDA(At, 1, 0); PG8_STAGE(PG8_SA(0, 1), a2 + hstepA, voffA);
            PG8_WAIT_L(8); PG8_BAR; PG8_WAIT_L(0); PG8_MMA(0, 0, At, B0); PG8_BAR; PG8_SCHED;
            PG8_LDB(B1, 1, 1); PG8_STAGE(PG8_SB(1, 0), b3, voffB);
            PG8_BAR; PG8_WAIT_L(0); PG8_MMA(0, 1, At, B1); PG8_BAR;
            PG8_LDA(At, 1, 1); PG8_STAGE(PG8_SA(1, 0), a3, voffA);
            PG8_BAR; PG8_WAIT_L(0); PG8_MMA(1, 0, At, B0); PG8_BAR; PG8_SCHED;
            PG8_STAGE(PG8_SB(1, 1), b3 + hstep, voffB);
            PG8_WAIT_V(6); PG8_BAR; PG8_MMA(1, 1, At, B1); PG8_BAR;
            }
        }
        if constexpr (ALIGN_EPI) { if (wr == 0) PG8_BAR; }
        if constexpr (!Epi::AFTER_DRAIN) { E(acc, cur, wr, wc, fr, fq); S.done(cur); }
        if (!has_next) break;
#pragma unroll
        for (int a = 0; a < 2; ++a)
#pragma unroll
            for (int b = 0; b < 2; ++b)
#pragma unroll
                for (int m = 0; m < 4; ++m)
#pragma unroll
                    for (int n = 0; n < 2; ++n) acc[a][b][m][n] = (f32x4){0.f, 0.f, 0.f, 0.f};
        cur = nxt; cA = nA; cB = nB; ++ui;
        if constexpr (ALIGN_EPI) { if (wr == 1) PG8_BAR; }
    }
    PG8_WAIT_V(0);
    if constexpr (!ALIGN_EPI) { if (wr == 0) PG8_BAR; }
    PG8_BAR;
    if constexpr (Epi::AFTER_DRAIN) { E.fused(acc, cur, wr, wc, fr, fq, lds, wid, lane); S.done(cur); }
#undef PG8_SA
#undef PG8_SB
#undef PG8_STAGE
#undef PG8_LDA
#undef PG8_LDB
#undef PG8_MMA
#undef PG8_WAIT_V
#undef PG8_WAIT_L
#undef PG8_BAR
#undef PG8_SCHED
}
}

#define DI __device__ __forceinline__
typedef pg8::bf16_t bf16_t;
typedef pg8::f32x4 f32x4;
typedef pg8::u32x4 u32x4;
typedef unsigned u32x2 __attribute__((ext_vector_type(2)));
#define LAS __attribute__((address_space(3)))

constexpr int DM = 1024, SEQ = 8192, NBATCH = 2, CTXL = 256;
constexpr int RL = NBATCH * SEQ;
constexpr int RT = RL + NBATCH * CTXL;
constexpr int FH = 2816, ABW = 2304;
constexpr float EPS = 1e-6f, LOG2E = 1.4426950408889634f;
constexpr int NWAVES = 8, NTHR = 512;
constexpr int LDS_BYTES = 147456;

constexpr size_t MiB = 1u << 20;
constexpr size_t OFF_MOD = 0;
constexpr size_t OFF_TAB_AB = 147456;
constexpr size_t OFF_TAB_C = 163840;
constexpr size_t OFF_BAR = 196608;
constexpr size_t OFF_KR = 1 * MiB;
constexpr size_t OFF_XSC = 3 * MiB;
constexpr size_t OFF_W = 5 * MiB;
constexpr size_t W_ABIN = OFF_W;
constexpr size_t W_ABOUT = W_ABIN + (size_t)2304 * 1024 * 2;
constexpr size_t W_13 = W_ABOUT + (size_t)1024 * 1024 * 2;
constexpr size_t W_2 = W_13 + (size_t)2 * 5632 * 1024 * 2;
constexpr size_t W_MIN = W_2 + (size_t)2 * 1024 * 2816 * 2;
constexpr size_t W_QB = W_MIN + (size_t)768 * 1024 * 2;
constexpr size_t W_KVB = W_QB + (size_t)1536 * 384 * 2;
constexpr size_t W_MOUT = W_KVB + (size_t)2048 * 256 * 2;
constexpr size_t W_END = W_MOUT + (size_t)1024 * 1024 * 2;
constexpr size_t OFF_HXR = 52 * MiB;
constexpr size_t OFF_YR = 85 * MiB;
constexpr size_t OFF_BIG = 151 * MiB;
constexpr size_t WS_END = OFF_BIG + (size_t)RT * FH * 2;
static_assert(W_END <= OFF_HXR && WS_END <= 256 * MiB, "ws map");
constexpr size_t OFF_QL = OFF_HXR, OFF_KVL = OFF_HXR + (size_t)RT * 384 * 2;

#define XB_TMO      128
#define XB_XCNT(j)  (256  + 64 * (j))
#define XB_XSUB(j)  (1280 + 64 * (j))
#define XB_XGEN(j)  (2304 + 64 * (j))
#define XB_TOP      3328
#define XB_TOPGEN   3392
#define XCD_BAR_WORDS 3456
#define XB_SPIN_CAP (1u << 18)

__device__ __forceinline__ unsigned xb_ld(unsigned* p)              { return __hip_atomic_load(p, __ATOMIC_RELAXED, __HIP_MEMORY_SCOPE_AGENT); }
__device__ __forceinline__ unsigned xb_add(unsigned* p, unsigned v) { return __hip_atomic_fetch_add(p, v, __ATOMIC_RELAXED, __HIP_MEMORY_SCOPE_AGENT); }
__device__ __forceinline__ unsigned xb_xcc_id() { return (unsigned)__builtin_amdgcn_s_getreg((3 << 11) | 20) & 0xFu; }
#define XB_SPIN(cond, bar) do { unsigned _sp = 0; while (cond) { __builtin_amdgcn_s_sleep(1); \
    if ((++_sp & 255u) == 0u) { if (xb_ld(&(bar)[XB_TMO])) break; if (_sp > XB_SPIN_CAP) { atomicAdd(&(bar)[XB_TMO], 1u); break; } } } } while (0)

struct XcdBarrier {
    unsigned* bar; unsigned x;
    volatile LAS unsigned* st;
};

__device__ __forceinline__ XcdBarrier xcd_barrier_post(unsigned* bar, volatile LAS unsigned* st) {
    XcdBarrier b; b.bar = bar; b.x = xb_xcc_id(); b.st = st;
    if (threadIdx.x == 0) (void)xb_add(&bar[XB_XCNT(b.x)], 1u);
    return b;
}
__device__ __forceinline__ void xcd_barrier_complete(unsigned* bar, unsigned x, unsigned& nloc, unsigned& nx) {
    const unsigned G = gridDim.x * gridDim.y * gridDim.z;
    unsigned sum, cnt, mine, sp = 0u;
    for (;;) {
        sum = 0u; cnt = 0u; mine = 0u;
#pragma unroll
        for (unsigned j = 0; j < 16; ++j) { const unsigned c = xb_ld(&bar[XB_XCNT(j)]); sum += c; cnt += (c > 0u) ? 1u : 0u; mine = (j == x) ? c : mine; }
        if (sum == G) break;
        __builtin_amdgcn_s_sleep(1);
        if ((++sp & 255u) == 0u) { if (xb_ld(&bar[XB_TMO])) break; if (sp > XB_SPIN_CAP) { atomicAdd(&bar[XB_TMO], 1u); break; } }
    }
    nloc = mine > 0u ? mine : 1u; nx = cnt > 0u ? cnt : 1u;
}

__device__ __forceinline__ void xcd_barrier(const XcdBarrier& b) {
    asm volatile("s_waitcnt vmcnt(0)" ::: "memory");
    __syncthreads();
    if (threadIdx.x == 0) {
        unsigned* bar = b.bar;
        __builtin_amdgcn_s_waitcnt(0);
        unsigned nloc = b.st[0], nx = b.st[1];
        if (nloc == 0u) { xcd_barrier_complete(bar, b.x, nloc, nx); b.st[0] = nloc; b.st[1] = nx; }
        const unsigned old = xb_add(&bar[XB_XSUB(b.x)], 1u);
        const unsigned gen = old / nloc;
        if (old + 1u == (gen + 1u) * nloc) {
            __builtin_amdgcn_fence(__ATOMIC_RELEASE, "agent");
            asm volatile("s_waitcnt vmcnt(0)" ::: "memory");
            const unsigned og = xb_add(&bar[XB_TOP], 1u);
            const unsigned tg = og / nx;
            if (og + 1u == (tg + 1u) * nx) xb_add(&bar[XB_TOPGEN], 1u);
            else XB_SPIN(xb_ld(&bar[XB_TOPGEN]) == tg, bar);
            __builtin_amdgcn_fence(__ATOMIC_ACQUIRE, "agent");
            xb_add(&bar[XB_XGEN(b.x)], 1u);
            asm volatile("s_waitcnt vmcnt(0)" ::: "memory");
        } else {
            XB_SPIN(xb_ld(&bar[XB_XGEN(b.x)]) == gen, bar);
            __builtin_amdgcn_fence(__ATOMIC_ACQUIRE, "agent");
            asm volatile("s_waitcnt vmcnt(0)" ::: "memory");
        }
    }
    __syncthreads();
}

constexpr int LDS_ST_OFF = 131072 + 512;

struct EpiF32 {
    static constexpr bool PERM = false, AFTER_DRAIN = false;
    float* O; int ldc;
    DI void operator()(const f32x4 (&acc)[2][2][4][2], const pg8::Unit& u, int wr, int wc, int fr_, int fq_) const {
        int fr = fr_, fq = fq_; asm volatile("" : "+v"(fr), "+v"(fq));
        const int row0 = u.pm * 256 + wr * 64 + fr, col0 = u.pn * 256 + wc * 32 + 4 * fq;
#pragma unroll
        for (int ai = 0; ai < 2; ++ai)
#pragma unroll
            for (int m = 0; m < 4; ++m) { float* rowp = O + (size_t)(row0 + ai * 128 + m * 16) * ldc + col0;
#pragma unroll
                for (int bj = 0; bj < 2; ++bj)
#pragma unroll
                    for (int n = 0; n < 2; ++n) *(f32x4*)(rowp + bj * 128 + n * 16) = acc[ai][bj][m][n]; }
    }
};
struct EpiBf16P {
    static constexpr bool PERM = true, AFTER_DRAIN = false;
    bf16_t* O; int ldc;
    DI void operator()(const f32x4 (&acc)[2][2][4][2], const pg8::Unit& u, int wr, int wc, int fr_, int fq_) const {
        int fr = fr_, fq = fq_; asm volatile("" : "+v"(fr), "+v"(fq));
        const int row0 = u.pm * 256 + wr * 64 + fr, col0 = u.pn * 256 + wc * 32 + 8 * fq;
#pragma unroll
        for (int ai = 0; ai < 2; ++ai)
#pragma unroll
            for (int m = 0; m < 4; ++m) { bf16_t* rowp = O + (size_t)(row0 + ai * 128 + m * 16) * ldc + col0;
#pragma unroll
                for (int bj = 0; bj < 2; ++bj) { const f32x4 v0 = acc[ai][bj][m][0], v1 = acc[ai][bj][m][1]; u32x4 w;
                    w.x = pg8::cvt_pk_bf16(v0[0], v0[1]); w.y = pg8::cvt_pk_bf16(v0[2], v0[3]); w.z = pg8::cvt_pk_bf16(v1[0], v1[1]); w.w = pg8::cvt_pk_bf16(v1[2], v1[3]);
                    *(u32x4*)(rowp + bj * 128) = w; } }
    }
};
DI float silu_f(float g) { return g / (1.0f + __expf(-g)); }
struct EpiSwiGLU {
    static constexpr bool PERM = true, AFTER_DRAIN = false;
    bf16_t* O; int ldc;
    DI void operator()(const f32x4 (&acc)[2][2][4][2], const pg8::Unit& u, int wr, int wc, int fr_, int fq_) const {
        int fr = fr_, fq = fq_; asm volatile("" : "+v"(fr), "+v"(fq));
        const int row0 = u.pm * 256 + wr * 64 + fr, col0 = u.pn * 128 + wc * 32 + 8 * fq;
#pragma unroll
        for (int ai = 0; ai < 2; ++ai)
#pragma unroll
            for (int m = 0; m < 4; ++m) { bf16_t* rowp = O + (size_t)(row0 + ai * 128 + m * 16) * ldc + col0;
                const f32x4 g0 = acc[ai][0][m][0], g1 = acc[ai][0][m][1], u0 = acc[ai][1][m][0], u1 = acc[ai][1][m][1]; u32x4 w;
                w.x = pg8::cvt_pk_bf16(silu_f(g0[0]) * u0[0], silu_f(g0[1]) * u0[1]); w.y = pg8::cvt_pk_bf16(silu_f(g0[2]) * u0[2], silu_f(g0[3]) * u0[3]);
                w.z = pg8::cvt_pk_bf16(silu_f(g1[0]) * u1[0], silu_f(g1[1]) * u1[1]); w.w = pg8::cvt_pk_bf16(silu_f(g1[2]) * u1[2], silu_f(g1[3]) * u1[3]);
                *(u32x4*)rowp = w; }
    }
};
typedef float f32x2v __attribute__((ext_vector_type(2)));
struct EpiQKV {
    static constexpr bool PERM = false, AFTER_DRAIN = false;
    bf16_t* O; const float* tab;
    DI void operator()(const f32x4 (&acc)[2][2][4][2], const pg8::Unit& u, int wr, int wc, int fr_, int fq_) const {
        int fr = fr_, fq = fq_; asm volatile("" : "+v"(fr), "+v"(fq));
        const int row0 = u.pm * 256 + wr * 64 + fr;
#pragma unroll
        for (int bj = 0; bj < 2; ++bj) {
            const int cb = u.pn * 256 + bj * 128;
            const bool rope = (cb < 1152) || (cb >= 1280 && cb < 1792);
            const float sc = cb < 1024 ? 0.125f * LOG2E : 1.0f;
#pragma unroll
            for (int ai = 0; ai < 2; ++ai)
#pragma unroll
                for (int m = 0; m < 4; ++m) {
                    const int row = row0 + ai * 128 + m * 16;
                    f32x4 v0 = acc[ai][bj][m][0], v1 = acc[ai][bj][m][1];
                    if (rope && row < RL) {
                        const int t = row & (SEQ - 1), pos = (wc & 1) ? (t & 63) : (t >> 6);
                        const float* tp = tab + (size_t)(pos * 16 + 4 * fq) * 2;
                        const f32x4 cs01 = *(const f32x4*)tp, cs23 = *(const f32x4*)(tp + 4);
                        const f32x4 cs = {cs01[0], cs01[2], cs23[0], cs23[2]}, sn = {cs01[1], cs01[3], cs23[1], cs23[3]};
                        const f32x4 o0 = v0 * cs - v1 * sn, o1 = v1 * cs + v0 * sn; v0 = o0; v1 = o1;
                    }
                    v0 = v0 * sc; v1 = v1 * sc;
                    bf16_t* p = O + (size_t)row * ABW + cb + wc * 32 + 4 * fq;
                    u32x2 w0, w1; w0.x = pg8::cvt_pk_bf16(v0[0], v0[1]); w0.y = pg8::cvt_pk_bf16(v0[2], v0[3]); w1.x = pg8::cvt_pk_bf16(v1[0], v1[1]); w1.y = pg8::cvt_pk_bf16(v1[2], v1[3]);
                    *(u32x2*)p = w0; *(u32x2*)(p + 16) = w1;
                }
        }
    }
};
struct EpiMlaQ {
    static constexpr bool PERM = false, AFTER_DRAIN = false;
    bf16_t* O; const float* tab;
    DI void operator()(const f32x4 (&acc)[2][2][4][2], const pg8::Unit& u, int wr, int wc, int fr_, int fq_) const {
        int fr = fr_, fq = fq_; asm volatile("" : "+v"(fr), "+v"(fq));
        const int row0 = u.pm * 256 + wr * 64 + fr;
        const float sc = 0.10206207261596575f * LOG2E;
#pragma unroll
        for (int bj = 0; bj < 2; ++bj) {
            const int cb = u.pn * 256 + bj * 128, G = (cb >> 5) + wc;
            const bool rope = (G % 3) == 2;
#pragma unroll
            for (int ai = 0; ai < 2; ++ai)
#pragma unroll
                for (int m = 0; m < 4; ++m) {
                    const int row = row0 + ai * 128 + m * 16;
                    f32x4 v0 = acc[ai][bj][m][0], v1 = acc[ai][bj][m][1];
                    if (rope) {
                        const int t = row & (SEQ - 1), pos = (fq & 2) ? (t & 63) : (t >> 6);
                        const float* tp = tab + (size_t)(pos * 8 + 4 * (fq & 1)) * 2;
                        const f32x4 cs01 = *(const f32x4*)tp, cs23 = *(const f32x4*)(tp + 4);
                        const f32x4 cs = {cs01[0], cs01[2], cs23[0], cs23[2]}, sn = {cs01[1], cs01[3], cs23[1], cs23[3]};
                        const f32x4 o0 = v0 * cs - v1 * sn, o1 = v1 * cs + v0 * sn; v0 = o0; v1 = o1;
                    }
                    v0 = v0 * sc; v1 = v1 * sc;
                    bf16_t* p = O + (size_t)row * 1536 + cb + wc * 32 + 4 * fq;
                    u32x2 w0, w1; w0.x = pg8::cvt_pk_bf16(v0[0], v0[1]); w0.y = pg8::cvt_pk_bf16(v0[2], v0[3]); w1.x = pg8::cvt_pk_bf16(v1[0], v1[1]); w1.y = pg8::cvt_pk_bf16(v1[2], v1[3]);
                    *(u32x2*)p = w0; *(u32x2*)(p + 16) = w1;
                }
        }
    }
};

template <class Epi>
DI void run_gemm(LAS unsigned char* lds, const bf16_t* A, int lda, const bf16_t* Bt, int M, int N, int K, const Epi& E) {
    int bx_ = blockIdx.x; asm volatile("" : "+s"(bx_));
    asm volatile("" : "+s"(M), "+s"(N), "+s"(K), "+s"(lda));
    pg8::Gemm g{A, Bt, M, N, K, lda}; pg8::StaticOrder S; S.init(M, N, (int)gridDim.x, bx_);
    pg8::gemm_phase<Epi, pg8::StaticOrder, true, true>(lds, g, S, E);
}

namespace att {
using bf16x8 = __attribute__((ext_vector_type(8))) short;
using s16x4 = __attribute__((ext_vector_type(4))) short;
using f32x16 = __attribute__((ext_vector_type(16))) float;
#define SBAR() __builtin_amdgcn_sched_barrier(0)
#ifndef ATT_MSUM_ALL
#define ATT_MSUM_ALL 1
#endif
#define LBAR() asm volatile("s_waitcnt lgkmcnt(0)\n\ts_barrier" ::: "memory")
constexpr float THR = 11.5f, NEGBIG = -1e30f;
DI int crow(int r, int hi) { return (r & 3) + 8 * (r >> 2) + 4 * hi; }
DI unsigned cvtpk(float lo, float hi) { unsigned r; asm volatile("v_cvt_pk_bf16_f32 %0, %1, %2" : "=v"(r) : "v"(lo), "v"(hi)); return r; }
DI int kswz64(int row, int colB) { return row * 128 + (colB ^ (((row >> 1) & 7) << 4)); }
DI int kswz32(int row, int chunk) { return row * 64 + ((chunk ^ ((row >> 2) & 3)) << 4); }

DI void partialSM(f32x16& p0, f32x16& p1, float& m_reg, float& alpha) {
    if (__builtin_expect(!__all(m_reg == 0.f), 0)) {
#pragma unroll
        for (int r = 0; r < 16; ++r) { p0[r] -= m_reg; p1[r] -= m_reg; }
    }
    float pmax = p0[0];
#pragma unroll
    for (int r = 1; r < 16; ++r) pmax = fmaxf(pmax, p0[r]);
#pragma unroll
    for (int r = 0; r < 16; ++r) pmax = fmaxf(pmax, p1[r]);
    { auto rr = __builtin_amdgcn_permlane32_swap(__float_as_uint(pmax), __float_as_uint(pmax), false, false);
      pmax = fmaxf(__uint_as_float(rr[0]), __uint_as_float(rr[1])); }
    alpha = 1.f;
    if (__builtin_expect(!__all(pmax <= THR), 0)) {
        const float dl = fmaxf(pmax, 0.f); m_reg += dl; alpha = __builtin_amdgcn_exp2f(-dl);
#pragma unroll
        for (int r = 0; r < 16; ++r) { p0[r] -= dl; p1[r] -= dl; }
    }
#pragma unroll
    for (int r = 0; r < 16; ++r) p0[r] = __builtin_amdgcn_exp2f(p0[r]);
}
template <bool VSUM>
DI void finishSM(f32x16& p0, f32x16& p1, float alpha, float& l_reg, bf16x8& pa0, bf16x8& pa1, bf16x8& pa2, bf16x8& pa3) {
#pragma unroll
    for (int r = 0; r < 16; ++r) p1[r] = __builtin_amdgcn_exp2f(p1[r]);
    if constexpr (VSUM) {
        float ps = 0;
#pragma unroll
        for (int r = 0; r < 16; ++r) ps += p0[r];
#pragma unroll
        for (int r = 0; r < 16; ++r) ps += p1[r];
        { auto rr = __builtin_amdgcn_permlane32_swap(__float_as_uint(ps), __float_as_uint(ps), false, false);
          ps = __uint_as_float(rr[0]) + __uint_as_float(rr[1]); }
        l_reg = l_reg * alpha + ps;
    }
#define PK4(P, BASE, OUT) do { unsigned a0 = cvtpk(P[BASE + 0], P[BASE + 1]), a1 = cvtpk(P[BASE + 2], P[BASE + 3]);   \
    unsigned b0 = cvtpk(P[BASE + 4], P[BASE + 5]), b1 = cvtpk(P[BASE + 6], P[BASE + 7]);                              \
    auto r0 = __builtin_amdgcn_permlane32_swap(a0, b0, false, false); auto r1 = __builtin_amdgcn_permlane32_swap(a1, b1, false, false); \
    u32x4 w = {r0[0], r1[0], r0[1], r1[1]}; OUT = __builtin_bit_cast(bf16x8, w); } while (0)
    PK4(p0, 0, pa0); PK4(p0, 8, pa1); PK4(p1, 0, pa2); PK4(p1, 8, pa3);
#undef PK4
}
template <int DK2>
DI void qkt(f32x16& p0, f32x16& p1, const char* K1b, const char* K2b, const bf16x8* qr, int r32, int hi) {
    p0 = f32x16{}; p1 = f32x16{};
#pragma unroll
    for (int d0 = 0; d0 < 4; ++d0) { const int cb = d0 * 32 + hi * 16;
        const bf16x8 b0 = *reinterpret_cast<const bf16x8*>(K1b + kswz64(r32, cb));
        const bf16x8 b1 = *reinterpret_cast<const bf16x8*>(K1b + kswz64(32 + r32, cb));
        p0 = __builtin_amdgcn_mfma_f32_32x32x16_bf16(b0, qr[d0], p0, 0, 0, 0);
        p1 = __builtin_amdgcn_mfma_f32_32x32x16_bf16(b1, qr[d0], p1, 0, 0, 0); }
    if constexpr (DK2 > 0) {
#pragma unroll
        for (int d0 = 0; d0 < 2; ++d0) { const int ch = d0 * 2 + hi;
            const bf16x8 b0 = *reinterpret_cast<const bf16x8*>(K2b + kswz32(r32, ch));
            const bf16x8 b1 = *reinterpret_cast<const bf16x8*>(K2b + kswz32(32 + r32, ch));
            p0 = __builtin_amdgcn_mfma_f32_32x32x16_bf16(b0, qr[4 + d0], p0, 0, 0, 0);
            p1 = __builtin_amdgcn_mfma_f32_32x32x16_bf16(b1, qr[4 + d0], p1, 0, 0, 0); }
    }
}
DI void wmask(f32x16& p0, f32x16& p1, int kp, int qp, int hi) {
#pragma unroll
    for (int r = 0; r < 16; ++r) { const int d0 = kp + crow(r, hi) - qp, d1 = d0 + 32;
        if (d0 > 128 || d0 < -128) p0[r] = NEGBIG;
        if (d1 > 128 || d1 < -128) p1[r] = NEGBIG; }
}
template <int NC> DI int v_st(int k, int c) { const int kk = (k & ~0xC) | ((k & 4) << 1) | ((k & 8) >> 1); return ((kk >> 3) * NC + (c >> 5)) * 512 + ((kk & 7) * 32 + (c & 31)) * 2; }
DI int v_rd_base(int lane) { return ((lane & 3) << 3) | (((lane >> 2) & 3) << 6) | (((lane >> 4) & 1) << 5) | (((lane >> 5) & 1) << 8); }
template <int OFF> DI s16x4 tr_read(int vb) { s16x4 r; asm volatile("ds_read_b64_tr_b16 %0, %1 offset:%2" : "=&v"(r) : "v"(vb), "i"(OFF) : "memory"); return r; }
template <int NC, int D0> DI void pv_one(f32x16& od, int vb, bf16x8 pa0, bf16x8 pa1, bf16x8 pa2, bf16x8 pa3) {
    constexpr int KS = 2 * NC * 512, HF = NC * 512, B0 = D0 * 512;
    const s16x4 l0 = tr_read<B0 + 0 * KS>(vb), h0 = tr_read<B0 + 0 * KS + HF>(vb), l1 = tr_read<B0 + 1 * KS>(vb), h1 = tr_read<B0 + 1 * KS + HF>(vb);
    const s16x4 l2 = tr_read<B0 + 2 * KS>(vb), h2 = tr_read<B0 + 2 * KS + HF>(vb), l3 = tr_read<B0 + 3 * KS>(vb), h3 = tr_read<B0 + 3 * KS + HF>(vb);
    asm volatile("s_waitcnt lgkmcnt(0)" ::: "memory"); SBAR();
#define PKV(L, H) (bf16x8){L[0], L[1], L[2], L[3], H[0], H[1], H[2], H[3]}
    od = __builtin_amdgcn_mfma_f32_32x32x16_bf16(pa0, PKV(l0, h0), od, 0, 0, 0);
    od = __builtin_amdgcn_mfma_f32_32x32x16_bf16(pa1, PKV(l1, h1), od, 0, 0, 0);
    od = __builtin_amdgcn_mfma_f32_32x32x16_bf16(pa2, PKV(l2, h2), od, 0, 0, 0);
    od = __builtin_amdgcn_mfma_f32_32x32x16_bf16(pa3, PKV(l3, h3), od, 0, 0, 0);
#undef PKV
}
DI void lsum_mfma(f32x16& ls, bf16x8 pa0, bf16x8 pa1, bf16x8 pa2, bf16x8 pa3) {
    const bf16x8 ones = {0x3F80, 0x3F80, 0x3F80, 0x3F80, 0x3F80, 0x3F80, 0x3F80, 0x3F80};
    ls = __builtin_amdgcn_mfma_f32_32x32x16_bf16(pa0, ones, ls, 0, 0, 0); ls = __builtin_amdgcn_mfma_f32_32x32x16_bf16(pa1, ones, ls, 0, 0, 0);
    ls = __builtin_amdgcn_mfma_f32_32x32x16_bf16(pa2, ones, ls, 0, 0, 0); ls = __builtin_amdgcn_mfma_f32_32x32x16_bf16(pa3, ones, ls, 0, 0, 0);
}
template <int NC> DI void pv_all(f32x16* o, int vb, bf16x8 pa0, bf16x8 pa1, bf16x8 pa2, bf16x8 pa3) {
    pv_one<NC, 0>(o[0], vb, pa0, pa1, pa2, pa3); pv_one<NC, 1>(o[1], vb, pa0, pa1, pa2, pa3);
    if constexpr (NC == 4) { pv_one<NC, 2>(o[2], vb, pa0, pa1, pa2, pa3); pv_one<NC, 3>(o[3], vb, pa0, pa1, pa2, pa3); }
}

struct Job {
    const bf16_t* Q; int ldq;
    const bf16_t* K1; int ldk1;
    const bf16_t* K2; int ldk2;
    const bf16_t* V; int ldv;
    int row1, nt1, row2, nt2;
    int win, qpos0, kpos0;
    float m0, l0;
    int omode;
    bf16_t* Ob; int ldo;
    float* Of; int ldf;
    float lam; const float* subg;
};

template <int DK2, int DV>
DI void unit(const Job& J, char* lds) {
    constexpr int NC = DV / 32, NQ = (64 + DK2) / 16;
    constexpr int KB1 = 8192, KB2 = 4096, VBY = 64 * DV * 2;
    int tid = threadIdx.x; asm volatile("" : "+v"(tid));
    const int wid = tid >> 6, lane = tid & 63, r32 = lane & 31, hi = lane >> 5;
    char* K1s = lds; char* K2s = lds + 3 * KB1; char* Vs = lds + 3 * KB1 + 3 * KB2;
    float* wsf = (float*)(lds + 3 * KB1 + 3 * KB2 + 3 * VBY) + wid * 64; float* li_l = wsf; float* al_l = wsf + 32;
    constexpr bool MSUM = (ATT_MSUM_ALL || NC == 2);
    float m_reg = J.m0, l_reg = J.l0; f32x16 o[NC]; bf16x8 qr[NQ]; f32x16 lsum;
#pragma unroll
    for (int d = 0; d < NC; ++d) o[d] = f32x16{};
#pragma unroll
    for (int r = 0; r < 16; ++r) lsum[r] = J.l0;
    const bf16_t* Qw = J.Q + (size_t)(wid * 32 + r32) * J.ldq + hi * 8;
#pragma unroll
    for (int d0 = 0; d0 < NQ; ++d0) qr[d0] = *reinterpret_cast<const bf16x8*>(Qw + d0 * 16);
    const int kr = tid >> 3, kc = (tid & 7) * 8;
    const int k2r = (tid >> 2) & 63, k2c = (tid & 3) * 8;
    const int vr = (DV == 64) ? (tid >> 3) : (tid >> 4), vc = (DV == 64) ? (tid & 7) * 8 : (tid & 15) * 8;
    const int k1off = kswz64(kr, kc * 2), k2off = kswz32(k2r, tid & 3);
    const int vst0 = v_st<NC>(vr, vc), vst1 = v_st<NC>(32 + vr, vc);
    const int vb0 = (int)(uintptr_t)Vs + v_rd_base(lane);
    const int NT = J.nt1 + J.nt2;
    const int qp = J.qpos0 + wid * 32 + r32;
    struct { bf16x8 k1, k2, v0, v1; } sr_[2];
#define TROW(t) ((t) < J.nt1 ? J.row1 + 64 * (t) : J.row2 + 64 * ((t) - J.nt1))
#define SLOAD(i, t) do { const size_t rw_ = (size_t)TROW(t); \
        sr_[i].k1 = *reinterpret_cast<const bf16x8*>(J.K1 + (rw_ + kr) * J.ldk1 + kc); \
        if (DK2 > 0 && tid < 256) sr_[i].k2 = *reinterpret_cast<const bf16x8*>(J.K2 + (rw_ + k2r) * J.ldk2 + k2c); \
        sr_[i].v0 = *reinterpret_cast<const bf16x8*>(J.V + (rw_ + vr) * J.ldv + vc); \
        if (DV == 128) sr_[i].v1 = *reinterpret_cast<const bf16x8*>(J.V + (rw_ + 32 + vr) * J.ldv + vc); } while (0)
#define SWRITE(b, i) do { *reinterpret_cast<bf16x8*>(K1s + (b) * KB1 + k1off) = sr_[i].k1; \
        if (DK2 > 0 && tid < 256) *reinterpret_cast<bf16x8*>(K2s + (b) * KB2 + k2off) = sr_[i].k2; \
        *reinterpret_cast<bf16x8*>(Vs + (b) * VBY + vst0) = sr_[i].v0; \
        if (DV == 128) *reinterpret_cast<bf16x8*>(Vs + (b) * VBY + vst1) = sr_[i].v1; } while (0)
#define RESC(a) do { if (__any((a) < 1.f)) { if (hi == 0) al_l[r32] = (a); asm volatile("s_waitcnt lgkmcnt(0)" ::: "memory"); \
        _Pragma("unroll") for (int d = 0; d < NC; ++d) _Pragma("unroll") for (int r = 0; r < 16; ++r) o[d][r] *= al_l[crow(r, hi)]; \
        if (MSUM) { _Pragma("unroll") for (int r = 0; r < 16; ++r) lsum[r] *= al_l[crow(r, hi)]; } } } while (0)
#define MASK(P0, P1, t) do { if (J.win && (t) < J.nt1) wmask(P0, P1, J.kpos0 + 64 * (t), qp, hi); } while (0)
    f32x16 pA0, pA1, pB0, pB1; float alA, alB; bf16x8 pa0, pa1, pa2, pa3;
    int s_prev = 0, s_cur = 1, s_next = 2;
#define ROT3() do { const int t_ = s_prev; s_prev = s_cur; s_cur = s_next; s_next = t_; } while (0)
    SLOAD(0, 0); SWRITE(0, 0); LBAR();
    qkt<DK2>(pA0, pA1, K1s, K2s, qr, r32, hi); MASK(pA0, pA1, 0); partialSM(pA0, pA1, m_reg, alA);
    SLOAD(1, 1); if (2 < NT) SLOAD(0, 2);
    SWRITE(1, 1); RESC(alA); LBAR();
    for (int j = 1; j + 1 < NT; j += 2) {
        SBAR(); qkt<DK2>(pB0, pB1, K1s + s_cur * KB1, K2s + s_cur * KB2, qr, r32, hi); MASK(pB0, pB1, j);
        finishSM<!MSUM>(pA0, pA1, alA, l_reg, pa0, pa1, pa2, pa3); SBAR();
        SLOAD(1, j + 2); SBAR();
        pv_all<NC>(o, vb0 + s_prev * VBY, pa0, pa1, pa2, pa3); if (MSUM) lsum_mfma(lsum, pa0, pa1, pa2, pa3); partialSM(pB0, pB1, m_reg, alB);
        SWRITE(s_next, 0);
        RESC(alB); LBAR(); ROT3();
        SBAR(); qkt<DK2>(pA0, pA1, K1s + s_cur * KB1, K2s + s_cur * KB2, qr, r32, hi); MASK(pA0, pA1, j + 1);
        finishSM<!MSUM>(pB0, pB1, alB, l_reg, pa0, pa1, pa2, pa3); SBAR();
        if (j + 3 < NT) SLOAD(0, j + 3); SBAR();
        pv_all<NC>(o, vb0 + s_prev * VBY, pa0, pa1, pa2, pa3); if (MSUM) lsum_mfma(lsum, pa0, pa1, pa2, pa3); partialSM(pA0, pA1, m_reg, alA);
        SWRITE(s_next, 1);
        RESC(alA); LBAR(); ROT3();
    }
    SBAR(); qkt<DK2>(pB0, pB1, K1s + s_cur * KB1, K2s + s_cur * KB2, qr, r32, hi); MASK(pB0, pB1, NT - 1);
    finishSM<!MSUM>(pA0, pA1, alA, l_reg, pa0, pa1, pa2, pa3); SBAR();
    pv_all<NC>(o, vb0 + s_prev * VBY, pa0, pa1, pa2, pa3); if (MSUM) lsum_mfma(lsum, pa0, pa1, pa2, pa3); partialSM(pB0, pB1, m_reg, alB);
    RESC(alB);
    finishSM<!MSUM>(pB0, pB1, alB, l_reg, pa0, pa1, pa2, pa3); SBAR();
    pv_all<NC>(o, vb0 + s_cur * VBY, pa0, pa1, pa2, pa3); if (MSUM) lsum_mfma(lsum, pa0, pa1, pa2, pa3);
    LBAR();
#undef ROT3
    if (hi == 0) li_l[r32] = l_reg; asm volatile("s_waitcnt lgkmcnt(0)" ::: "memory");
    int tide = tid; asm volatile("" : "+v"(tide));
    const int r32e = tide & 31, hie = (tide >> 5) & 1, wide = tide >> 6;
    float rli[16];
#pragma unroll
    for (int r = 0; r < 16; ++r) rli[r] = MSUM ? 1.0f / lsum[r] : 1.0f / li_l[crow(r, hie)];
    if (J.omode == 0) {
        bf16_t* Ow = J.Ob + (unsigned)((wide * 32 + 4 * hie) * J.ldo + r32e);
#pragma unroll
        for (int r = 0; r < 16; ++r) { const unsigned ro = (unsigned)(((r & 3) + 8 * (r >> 2)) * J.ldo);
#pragma unroll
            for (int d0 = 0; d0 < NC; ++d0) Ow[ro + d0 * 32] = (bf16_t)(cvtpk(o[d0][r] * rli[r], 0.f) & 0xffffu); }
    } else if (J.omode == 1) {
        float* Ow = J.Of + (unsigned)((wide * 32 + 4 * hie) * J.ldf + r32e);
#pragma unroll
        for (int r = 0; r < 16; ++r) { const unsigned ro = (unsigned)(((r & 3) + 8 * (r >> 2)) * J.ldf);
#pragma unroll
            for (int d0 = 0; d0 < NC; ++d0) Ow[ro + d0 * 32] = o[d0][r] * rli[r]; }
    } else {
        const float* Fw = J.Of + (unsigned)((wide * 32 + 4 * hie) * J.ldf + r32e); bf16_t* Ow = J.Ob + (unsigned)((wide * 32 + 4 * hie) * J.ldo + r32e);
        float gv[NC];
#pragma unroll
        for (int d0 = 0; d0 < NC; ++d0) gv[d0] = J.subg[d0 * 32 + r32e] * 0.8f;
#pragma unroll
        for (int r = 0; r < 16; ++r) { const unsigned rf = (unsigned)(((r & 3) + 8 * (r >> 2)) * J.ldf), ro = (unsigned)(((r & 3) + 8 * (r >> 2)) * J.ldo); float val[NC]; float ss = 0.f;
#pragma unroll
            for (int d0 = 0; d0 < NC; ++d0) { val[d0] = Fw[rf + d0 * 32] - J.lam * (o[d0][r] * rli[r]); ss += val[d0] * val[d0]; }
            ss += __shfl_xor(ss, 1); ss += __shfl_xor(ss, 2); ss += __shfl_xor(ss, 4); ss += __shfl_xor(ss, 8); ss += __shfl_xor(ss, 16);
            const float rstd = 1.0f / sqrtf(ss * (1.0f / (32 * NC)) + EPS);
#pragma unroll
            for (int d0 = 0; d0 < NC; ++d0) Ow[ro + d0 * 32] = (bf16_t)(cvtpk(val[d0] * rstd * gv[d0], 0.f) & 0xffffu);
            asm volatile("" ::: "memory"); }
    }
#undef TROW
#undef SLOAD
#undef SWRITE
#undef RESC
#undef MASK
}
#undef SBAR
#undef LBAR
}

DI float wave_sum(float v) {
#pragma unroll
    for (int o = 1; o < 64; o <<= 1) v += __shfl_xor(v, o);
    return v;
}
DI unsigned pk2(float lo, float hi) { return pg8::cvt_pk_bf16(lo, hi); }

struct RowOp {
    const float* rin_lat; const float* rin_ctx;
    const float* Y; const float* gY; const float* gate;
    float* rout_lat; float* rout_ctx;
    const float* gN; const float* shift; const float* scale; bf16_t* H;
    int nrows;
};
DI void rowop_phase(const RowOp& P, int gw, int ngw, int lane) {
    for (int row = gw; row < P.nrows; row += ngw) {
        const int g = row < SEQ ? 0 : (row < RL ? 1 : 2);
        const float* xin = row < RL ? P.rin_lat + (size_t)row * DM : P.rin_ctx + (size_t)(row - RL) * DM;
        f32x4 x[4];
#pragma unroll
        for (int j = 0; j < 4; ++j) x[j] = *(const f32x4*)(xin + 4 * lane + 256 * j);
        if (P.Y) {
            f32x4 y[4]; float ss = 0.f;
#pragma unroll
            for (int j = 0; j < 4; ++j) { y[j] = *(const f32x4*)(P.Y + (size_t)row * DM + 4 * lane + 256 * j); ss += (y[j][0] * y[j][0] + y[j][1] * y[j][1]) + (y[j][2] * y[j][2] + y[j][3] * y[j][3]); }
            const float rstd = 1.0f / sqrtf(wave_sum(ss) * (1.0f / DM) + EPS);
#pragma unroll
            for (int j = 0; j < 4; ++j) { const f32x4 gy = *(const f32x4*)(P.gY + 4 * lane + 256 * j), gt = *(const f32x4*)(P.gate + g * 6144 + 4 * lane + 256 * j);
                x[j] = x[j] + gt * ((y[j] * rstd) * gy); }
        }
        float* xo = row < RL ? (P.rout_lat ? P.rout_lat + (size_t)row * DM : nullptr) : (P.rout_ctx ? P.rout_ctx + (size_t)(row - RL) * DM : nullptr);
        if (xo) {
#pragma unroll
            for (int j = 0; j < 4; ++j) *(f32x4*)(xo + 4 * lane + 256 * j) = x[j];
        }
        if (P.H) {
            float ss = 0.f;
#pragma unroll
            for (int j = 0; j < 4; ++j) ss += (x[j][0] * x[j][0] + x[j][1] * x[j][1]) + (x[j][2] * x[j][2] + x[j][3] * x[j][3]);
            const float rstd = 1.0f / sqrtf(wave_sum(ss) * (1.0f / DM) + EPS);
#pragma unroll
            for (int j = 0; j < 4; ++j) { const int c = 4 * lane + 256 * j;
                const f32x4 gn = *(const f32x4*)(P.gN + c), sh = *(const f32x4*)(P.shift + g * 6144 + c), sc = *(const f32x4*)(P.scale + g * 6144 + c);
                const f32x4 h = ((x[j] * rstd) * gn) * (sc + 1.0f) + sh;
                u32x2 w; w.x = pk2(h[0], h[1]); w.y = pk2(h[2], h[3]);
                *(u32x2*)(P.H + (size_t)row * DM + c) = w; }
        }
    }
}
DI void mla_prep_phase(const float* P1, const float* qg, const float* kvg, const float* tabc, bf16_t* QL, bf16_t* KVL, bf16_t* KR, int gw, int ngw, int lane) {
    for (int row = gw; row < RT; row += ngw) {
        const float* p = P1 + (size_t)row * 768 + 4 * lane;
        const f32x4 v0 = *(const f32x4*)p, v1 = *(const f32x4*)(p + 256), v2 = *(const f32x4*)(p + 512);
        const float s0 = (v0[0] * v0[0] + v0[1] * v0[1]) + (v0[2] * v0[2] + v0[3] * v0[3]);
        const float s1 = (v1[0] * v1[0] + v1[1] * v1[1]) + (v1[2] * v1[2] + v1[3] * v1[3]);
        const float s2 = (v2[0] * v2[0] + v2[1] * v2[1]) + (v2[2] * v2[2] + v2[3] * v2[3]);
        const float ssq = wave_sum(s0 + (lane < 32 ? s1 : 0.f));
        const float sskv = wave_sum((lane >= 32 ? s1 : 0.f) + (lane < 32 ? s2 : 0.f));
        const float rq = 1.0f / sqrtf(ssq * (1.0f / 384) + EPS), rkv = 1.0f / sqrtf(sskv * (1.0f / 256) + EPS);
        { const f32x4 g = *(const f32x4*)(qg + 4 * lane); const f32x4 h = (v0 * rq) * g; u32x2 w; w.x = pk2(h[0], h[1]); w.y = pk2(h[2], h[3]); *(u32x2*)(QL + (size_t)row * 384 + 4 * lane) = w; }
        if (lane < 32) { const f32x4 g = *(const f32x4*)(qg + 256 + 4 * lane); const f32x4 h = (v1 * rq) * g; u32x2 w; w.x = pk2(h[0], h[1]); w.y = pk2(h[2], h[3]); *(u32x2*)(QL + (size_t)row * 384 + 256 + 4 * lane) = w; }
        else { const f32x4 g = *(const f32x4*)(kvg + 4 * (lane - 32)); const f32x4 h = (v1 * rkv) * g; u32x2 w; w.x = pk2(h[0], h[1]); w.y = pk2(h[2], h[3]); *(u32x2*)(KVL + (size_t)row * 256 + 4 * (lane - 32)) = w; }
        if (lane < 32) { const f32x4 g = *(const f32x4*)(kvg + 128 + 4 * lane); const f32x4 h = (v2 * rkv) * g; u32x2 w; w.x = pk2(h[0], h[1]); w.y = pk2(h[2], h[3]); *(u32x2*)(KVL + (size_t)row * 256 + 128 + 4 * lane) = w; }
        f32x4 pr; pr[0] = __shfl_xor(v2[0], 2); pr[1] = __shfl_xor(v2[1], 2); pr[2] = __shfl_xor(v2[2], 2); pr[3] = __shfl_xor(v2[3], 2);
        if (lane >= 32 && lane < 40) {
            const int q = lane - 32; f32x4 h = v2;
            if (row < RL) {
                const int t = row & (SEQ - 1), pos = (q < 4) ? (t >> 6) : (t & 63);
                const float* tp = tabc + (size_t)(pos * 8 + 4 * (q & 1)) * 2;
                const f32x4 cs01 = *(const f32x4*)tp, cs23 = *(const f32x4*)(tp + 4);
                const f32x4 cs = {cs01[0], cs01[2], cs23[0], cs23[2]}, sn = {cs01[1], cs01[3], cs23[1], cs23[3]};
                const f32x4 sg = (q & 2) ? sn : -sn;
                h = v2 * cs + pr * sg;
            }
            u32x2 w; w.x = pk2(h[0], h[1]); w.y = pk2(h[2], h[3]); *(u32x2*)(KR + (size_t)row * 32 + 4 * q + ((q >> 1) == 1 ? 8 : ((q >> 1) == 2 ? -8 : 0))) = w;
        }
    }
}

DI void transpose_item(const float* W, int N, int k0, int n0, bf16_t* WT, int ldt, int orow0, LAS float* scr, int lane, bool perm = false) {
#pragma unroll 8
    for (int i = 0; i < 32; ++i) { const int kk = 2 * i + (lane >> 5); scr[kk * 33 + (lane & 31)] = W[(size_t)(k0 + kk) * N + n0 + (lane & 31)]; }
    asm volatile("s_waitcnt lgkmcnt(0)" ::: "memory");
    const int c = lane & 7;
#pragma unroll
    for (int j = 0; j < 4; ++j) { const int n = (lane >> 3) + 8 * j; const LAS float* s = scr + (8 * c) * 33 + n;
        u32x4 o; o.x = pk2(s[0 * 33], s[1 * 33]); o.y = pk2(s[2 * 33], s[3 * 33]); o.z = pk2(s[4 * 33], s[5 * 33]); o.w = pk2(s[6 * 33], s[7 * 33]);
        const int np = perm ? (((n >> 3) == 1) ? n + 8 : (((n >> 3) == 2) ? n - 8 : n)) : n;
        *(u32x4*)(WT + (size_t)(orow0 + np) * ldt + k0 + 8 * c) = o; }
    asm volatile("s_waitcnt lgkmcnt(0)" ::: "memory");
}
DI void sincos_acc(float ang, float& c, float& s) {
    const double a = (double)ang, twopi = 6.283185307179586476925287;
    const double k = __builtin_rint(a / twopi); const double r = a - k * twopi;
    const double r2 = r * r; double ts = r, tc = 1.0, ss = r, cc = 1.0;
#pragma unroll
    for (int i = 1; i <= 13; ++i) { tc = -tc * r2 / (double)((2 * i - 1) * (2 * i)); cc += tc; ts = -ts * r2 / (double)((2 * i) * (2 * i + 1)); ss += ts; }
    c = (float)cc; s = (float)ss;
}
__device__ const float INVF_AB[16] = {1.000000000e+00f, 5.623413324e-01f, 3.162277639e-01f, 1.778279394e-01f, 1.000000015e-01f, 5.623413250e-02f, 3.162277490e-02f, 1.778279431e-02f,
                                      9.999999776e-03f, 5.623413250e-03f, 3.162277630e-03f, 1.778279431e-03f, 1.000000047e-03f, 5.623413017e-04f, 3.162277571e-04f, 1.778279402e-04f};
__device__ const float INVF_C[8] = {1.000000000e+00f, 3.162277639e-01f, 1.000000015e-01f, 3.162277490e-02f, 9.999999776e-03f, 3.162277630e-03f, 1.000000047e-03f, 3.162277571e-04f};

struct Args { const float* in[20]; float* out; unsigned char* ws; int ph_lo, ph_hi; };

DI void prologue_phase(const Args& A, LAS unsigned char* lds) {
    int tid_ = threadIdx.x; asm volatile("" : "+v"(tid_));
    int bx_ = blockIdx.x; asm volatile("" : "+s"(bx_));
    const int tid = tid_, lane = tid & 63, wave = tid >> 6, G = gridDim.x, bx = bx_;
    unsigned char* ws = A.ws;
    {
        LAS float* sv = (LAS float*)lds;
        LAS float* red = (LAS float*)(lds + 16384);
        bool did = false;
        for (int item = bx; item < 192; item += G) {
            if (!did) {
                for (int i = tid; i < 3072; i += NTHR) { const float v = i < 2048 ? A.in[1][i] : A.in[3][i - 2048]; sv[i] = v / (1.0f + __expf(-v)); }
                __syncthreads(); did = true;
            }
            const int l = item / 96, n0 = (item % 96) * 64, c = lane, ks = wave;
            const float* W = A.in[4] + (size_t)l * 1024 * 6144 + n0 + c;
            float a0 = 0.f, a1 = 0.f, a2 = 0.f;
#pragma unroll 8
            for (int k = ks * 128; k < ks * 128 + 128; ++k) { const float w = W[(size_t)k * 6144]; a0 += sv[k] * w; a1 += sv[1024 + k] * w; a2 += sv[2048 + k] * w; }
            red[(ks * 3 + 0) * 64 + c] = a0; red[(ks * 3 + 1) * 64 + c] = a1; red[(ks * 3 + 2) * 64 + c] = a2;
            __syncthreads();
            if (tid < 192) { const int g = tid >> 6, cc = tid & 63; float s = A.in[5][l * 6144 + n0 + cc];
#pragma unroll
                for (int k8 = 0; k8 < 8; ++k8) s += red[(k8 * 3 + g) * 64 + cc];
                ((float*)(ws + OFF_MOD))[(size_t)(l * 3 + g) * 6144 + n0 + cc] = s; }
            __syncthreads();
        }
        __syncthreads();
    }
    if (bx == 0) { unsigned* bw = (unsigned*)(ws + OFF_BAR); for (int i = tid; i < XCD_BAR_WORDS; i += NTHR) bw[i] = 0u; }
    if (bx == G - 1) {
        float* tab = (float*)(ws + OFF_TAB_AB); float* tabc = (float*)(ws + OFF_TAB_C);
        for (int e = tid; e < 2048; e += NTHR) { const int pos = e >> 4, i = e & 15; float c, s; sincos_acc((float)pos * INVF_AB[i], c, s); tab[2 * e] = c; tab[2 * e + 1] = s; }
        for (int e = tid; e < 1024; e += NTHR) { const int pos = e >> 3, i = e & 7; float c, s; sincos_acc((float)pos * INVF_C[i], c, s); tabc[2 * e] = c; tabc[2 * e + 1] = s; }
    }
    { u32x4* z = (u32x4*)(ws + W_MIN + (size_t)672 * 1024 * 2); const u32x4 zero = {0u, 0u, 0u, 0u};
      for (int i = bx * NTHR + tid; i < 96 * 1024 * 2 / 16; i += G * NTHR) z[i] = zero; }
    {
        LAS float* scr = (LAS float*)(lds + wave * 16384);
        const int gw = bx * NWAVES + wave, ngw = G * NWAVES;
        constexpr int I1 = 16 * 72, I2 = 16 * 32, I3 = 16 * 176, I4 = 44 * 32, I5 = 16 * 21, I6 = 6 * 48, I7 = 4 * 64, I8 = 16 * 32;
        constexpr int NITEMS = I1 + I2 + 2 * I3 + 2 * I4 + I5 + I6 + I7 + I8;
        for (int it = gw; it < NITEMS; it += ngw) {
            int r = it;
            if (r < I1) { const int kb = r / 72, nb = r % 72; transpose_item(A.in[9], 2304, 64 * kb, 32 * nb, (bf16_t*)(ws + W_ABIN), 1024, 32 * nb, scr, lane); continue; } r -= I1;
            if (r < I2) { const int kb = r / 32, nb = r % 32; transpose_item(A.in[10], 1024, 64 * kb, 32 * nb, (bf16_t*)(ws + W_ABOUT), 1024, 32 * nb, scr, lane); continue; } r -= I2;
            if (r < 2 * I3) { const int l = r / I3, q = r % I3, kb = q / 176, nb = q % 176, n0 = 32 * nb, half = n0 / FH, rem = n0 % FH;
                transpose_item(A.in[7] + (size_t)l * 1024 * 5632, 5632, 64 * kb, n0, (bf16_t*)(ws + W_13) + (size_t)l * 5632 * 1024, 1024, 256 * (rem / 128) + 128 * half + (rem % 128), scr, lane); continue; } r -= 2 * I3;
            if (r < 2 * I4) { const int l = r / I4, q = r % I4, kb = q / 32, nb = q % 32;
                transpose_item(A.in[8] + (size_t)l * FH * 1024, 1024, 64 * kb, 32 * nb, (bf16_t*)(ws + W_2) + (size_t)l * 1024 * FH, FH, 32 * nb, scr, lane); continue; } r -= 2 * I4;
            if (r < I5) { const int kb = r / 21, nb = r % 21; transpose_item(A.in[14], 672, 64 * kb, 32 * nb, (bf16_t*)(ws + W_MIN), 1024, 32 * nb, scr, lane); continue; } r -= I5;
            if (r < I6) { const int kb = r / 48, nb = r % 48; transpose_item(A.in[17], 1536, 64 * kb, 32 * nb, (bf16_t*)(ws + W_QB), 384, 32 * nb, scr, lane, (nb % 3) == 2); continue; } r -= I6;
            if (r < I7) { const int kb = r / 64, nb = r % 64; transpose_item(A.in[18], 2048, 64 * kb, 32 * nb, (bf16_t*)(ws + W_KVB), 256, 32 * nb, scr, lane); continue; } r -= I7;
            { const int kb = r / 32, nb = r % 32; transpose_item(A.in[19], 1024, 64 * kb, 32 * nb, (bf16_t*)(ws + W_MOUT), 1024, 32 * nb, scr, lane); }
        }
    }
}

DI void attn_layer0_phase(const Args& A, char* lds) {
    int tid_ = threadIdx.x; asm volatile("" : "+v"(tid_));
    int bx_ = blockIdx.x; asm volatile("" : "+s"(bx_));
    unsigned char* ws = A.ws; const int G = gridDim.x, bx = bx_, lane = tid_ & 63;
    const bf16_t* PQ = (const bf16_t*)(ws + OFF_BIG); bf16_t* OA = (bf16_t*)(ws + OFF_HXR); float* OD = (float*)(ws + OFF_YR);
    const float* lv = A.in[12];
    const float lam = __expf(wave_sum(lv[lane] * lv[64 + lane])) - __expf(wave_sum(lv[128 + lane] * lv[192 + lane])) + 0.2f;
    const float* subg = A.in[13];
#ifndef NO_B
    for (int pu = bx; pu < 256 + 8; pu += G) {
        int b, hb, qrow0, ctxq;
        if (pu < 256) { const int x = pu & 7; b = x >> 2; hb = x & 3; qrow0 = b * SEQ + (pu >> 3) * 256; ctxq = 0; }
        else { const int x = pu - 256; b = x >> 2; hb = x & 3; qrow0 = RL + b * CTXL; ctxq = 1; }
#pragma unroll 1
        for (int mh = 0; mh < 2; ++mh) {
            att::Job J;
            J.Q = PQ + (size_t)qrow0 * ABW + 512 + hb * 128 + mh * 64; J.ldq = ABW;
            J.K1 = PQ + 1280 + hb * 128 + mh * 64; J.ldk1 = ABW; J.K2 = PQ; J.ldk2 = ABW;
            J.V = PQ + 1792 + hb * 128; J.ldv = ABW;
            if (ctxq) { J.row1 = RL + b * CTXL; J.nt1 = 4; J.row2 = 0; J.nt2 = 0; }
            else { J.row1 = b * SEQ; J.nt1 = SEQ / 64; J.row2 = RL + b * CTXL; J.nt2 = 4; }
            J.win = 0; J.qpos0 = 0; J.kpos0 = 0; J.m0 = 0.f; J.l0 = 0.f;
            J.omode = mh ? 2 : 1;
            J.Ob = OA + (size_t)qrow0 * DM + 512 + hb * 128; J.ldo = DM;
            J.Of = OD + (size_t)qrow0 * 512 + hb * 128; J.ldf = 512;
            J.lam = lam; J.subg = subg;
            att::unit<0, 128>(J, lds);
        }
    }
#endif
#ifndef NO_A
    for (int u = bx; u < 512 + 16; u += G) {
        att::Job J; int b, h, qrow0;
        if (u < 512) {
            const int qb = u & 31; h = (u >> 5) & 7; b = u >> 8; qrow0 = b * SEQ + qb * 256;
            const int k0 = qb * 256 - 128 < 0 ? 0 : qb * 256 - 128, k1 = qb * 256 + 384 > SEQ ? SEQ : qb * 256 + 384;
            J.row1 = b * SEQ + k0; J.nt1 = (k1 - k0) / 64; J.row2 = RL + b * CTXL; J.nt2 = 4; J.win = 1; J.qpos0 = qb * 256; J.kpos0 = k0;
        } else {
            const int x = u - 512; b = x >> 3; h = x & 7; qrow0 = RL + b * CTXL;
            J.row1 = RL + b * CTXL; J.nt1 = 4; J.row2 = 0; J.nt2 = 0; J.win = 0; J.qpos0 = 0; J.kpos0 = 0;
        }
        J.Q = PQ + (size_t)qrow0 * ABW + h * 64; J.ldq = ABW;
        J.K1 = PQ + 1024 + (h >> 2) * 64; J.ldk1 = ABW; J.K2 = PQ; J.ldk2 = ABW;
        J.V = PQ + 1152 + (h >> 2) * 64; J.ldv = ABW;
        J.m0 = 0.f; J.l0 = __expf(A.in[11][h]); J.omode = 0;
        J.Ob = OA + (size_t)qrow0 * DM + h * 64; J.ldo = DM; J.Of = OD; J.ldf = 512; J.lam = 0.f; J.subg = subg;
        att::unit<0, 64>(J, lds);
    }
#endif
}
DI void attn_mla_phase(const Args& A, char* lds) {
    int bx_ = blockIdx.x; asm volatile("" : "+s"(bx_));
    unsigned char* ws = A.ws; const int G = gridDim.x, bx = bx_;
    const bf16_t* Q1 = (const bf16_t*)(ws + OFF_YR); const bf16_t* KV = (const bf16_t*)(ws + OFF_BIG); const bf16_t* KR = (const bf16_t*)(ws + OFF_KR);
    bf16_t* OA = (bf16_t*)(ws + OFF_HXR);
    for (int u = bx; u < 1024; u += G) {
        const int i = u >> 8, cc = u & 255, bh = i * 8 + (cc & 7), qb = cc >> 3, b = bh >> 4, h = bh & 15, qrow0 = b * SEQ + qb * 256;
        att::Job J;
        J.Q = Q1 + (size_t)qrow0 * 1536 + h * 96; J.ldq = 1536;
        J.K1 = KV + h * 128; J.ldk1 = 2048; J.K2 = KR; J.ldk2 = 32; J.V = KV + h * 128 + 64; J.ldv = 2048;
        J.row1 = b * SEQ; J.nt1 = SEQ / 64; J.row2 = RL + b * CTXL; J.nt2 = 4; J.win = 0; J.qpos0 = 0; J.kpos0 = 0;
        J.m0 = 0.f; J.l0 = 0.f; J.omode = 0;
        J.Ob = OA + (size_t)qrow0 * DM + h * 64; J.ldo = DM; J.Of = nullptr; J.ldf = 0; J.lam = 0.f; J.subg = nullptr;
        att::unit<32, 64>(J, lds);
    }
}

DI int fresh_bx() { int b = blockIdx.x; asm volatile("" : "+s"(b)); return b; }
constexpr int N_PHASES = 18;
typedef const __attribute__((address_space(4))) Args* KArgsP;
DI Args load_args() {
#if defined(__HIP_DEVICE_COMPILE__)
    KArgsP p = (KArgsP)__builtin_amdgcn_kernarg_segment_ptr(); asm volatile("" : "+s"(p)); return *p;
#else
    return Args{};
#endif
}
DI bool phase_in(int k) {
#if defined(__HIP_DEVICE_COMPILE__)
    KArgsP p = (KArgsP)__builtin_amdgcn_kernarg_segment_ptr(); asm volatile("" : "+s"(p)); return p->ph_lo <= k && k < p->ph_hi;
#else
    return false;
#endif
}
__global__ void __launch_bounds__(NTHR, 2) dit_fwd(Args A_) {
    extern __shared__ __attribute__((aligned(16))) unsigned char lds_raw[];
    LAS unsigned char* lds = (LAS unsigned char*)lds_raw;
#ifndef DISMASK
#define DISMASK 0
#endif
#define EN(n) (!((DISMASK >> (n)) & 1))
#ifndef REPMASK
#define REPMASK 0
#endif
#define REP(n) _Pragma("unroll 1") for (int rep_ = 0; rep_ < ((((REPMASK) >> (n)) & 1) ? 2 : 1); ++rep_)
#define IN(k) phase_in(k)
    if (threadIdx.x < 2) ((volatile LAS unsigned*)(lds + LDS_ST_OFF))[threadIdx.x] = 0u;
    __syncthreads();
#define SEAM(k) do { if (IN(k) && IN((k) + 1)) { if ((k) == 0) { cg::this_grid().sync(); const Args Ab = load_args(); (void)xcd_barrier_post((unsigned*)(Ab.ws + OFF_BAR), (volatile LAS unsigned*)(lds + LDS_ST_OFF)); } \
    else { const Args Ab = load_args(); XcdBarrier bar_; bar_.bar = (unsigned*)(Ab.ws + OFF_BAR); bar_.x = xb_xcc_id(); bar_.st = (volatile LAS unsigned*)(lds + LDS_ST_OFF); xcd_barrier(bar_); } } } while (0)
#define FRESH() const Args A = load_args(); unsigned char* ws = A.ws; (void)ws; int tid_ = threadIdx.x; asm volatile("" : "+v"(tid_)); \
    const int lane = tid_ & 63, ngw = (int)gridDim.x * NWAVES, gw = fresh_bx() * NWAVES + __builtin_amdgcn_readfirstlane(tid_ >> 6); (void)lane; (void)gw; (void)ngw; \
    float* mod = (float*)(ws + OFF_MOD); bf16_t* HX = (bf16_t*)(ws + OFF_HXR); float* Y = (float*)(ws + OFF_YR); float* XSC = (float*)(ws + OFF_XSC); const float* normg = A.in[6]; \
    (void)mod; (void)HX; (void)Y; (void)XSC; (void)normg

    if (IN(0) && EN(0)) REP(0) { FRESH(); prologue_phase(A, lds); } SEAM(0);
    if (IN(1) && EN(1)) REP(1) {
        FRESH(); RowOp P{A.in[0], A.in[2], nullptr, nullptr, nullptr, nullptr, nullptr, normg, mod + 0 * 1024, mod + 1 * 1024, HX, RT};
        rowop_phase(P, gw, ngw, lane);
    } SEAM(1);
#pragma unroll 1
    for (int l = 0; l < 2; ++l) {
        const int pb = l == 0 ? 4 : 13;
        if (l == 0) {
            if (IN(2) && EN(2)) REP(2) { FRESH(); EpiQKV E{(bf16_t*)(ws + OFF_BIG), (const float*)(ws + OFF_TAB_AB)}; run_gemm(lds, HX, DM, (const bf16_t*)(ws + W_ABIN), RT, ABW, DM, E); } SEAM(2);
            if (IN(3) && EN(3)) REP(3) { FRESH(); attn_layer0_phase(A, (char*)lds_raw); } SEAM(3);
        } else {
            if (IN(9) && EN(9)) REP(9) { FRESH(); EpiF32 E{(float*)(ws + OFF_BIG), 768}; run_gemm(lds, HX, DM, (const bf16_t*)(ws + W_MIN), RT, 768, DM, E); } SEAM(9);
            if (IN(10) && EN(10)) REP(10) { FRESH(); mla_prep_phase((const float*)(ws + OFF_BIG), A.in[15], A.in[16], (const float*)(ws + OFF_TAB_C), (bf16_t*)(ws + OFF_QL), (bf16_t*)(ws + OFF_KVL), (bf16_t*)(ws + OFF_KR), gw, ngw, lane); } SEAM(10);
            if (IN(11) && EN(11)) REP(11) {
                { FRESH(); EpiMlaQ E{(bf16_t*)(ws + OFF_YR), (const float*)(ws + OFF_TAB_C)}; run_gemm(lds, (const bf16_t*)(ws + OFF_QL), 384, (const bf16_t*)(ws + W_QB), RL, 1536, 384, E); }
                { FRESH(); EpiBf16P E{(bf16_t*)(ws + OFF_BIG), 2048}; run_gemm(lds, (const bf16_t*)(ws + OFF_KVL), 256, (const bf16_t*)(ws + W_KVB), RT, 2048, 256, E); }
            } SEAM(11);
            if (IN(12) && EN(12)) REP(12) { FRESH(); attn_mla_phase(A, (char*)lds_raw); } SEAM(12);
        }
        const int M_l = l == 0 ? RT : RL;
        if (IN(pb) && EN(4)) REP(4) { FRESH(); EpiF32 E{Y, DM}; run_gemm(lds, HX  , DM, (const bf16_t*)(ws + (l == 0 ? W_ABOUT : W_MOUT)), M_l, DM, DM, E); } SEAM(pb);
        if (IN(pb + 1) && EN(5)) REP(5) {
            FRESH(); const float* modl = mod + (size_t)l * 3 * 6144;
            RowOp P{l == 0 ? A.in[0] : A.out, l == 0 ? A.in[2] : XSC, Y, normg + (l * 4 + 1) * DM, modl + 2 * 1024, A.out, XSC,
                    normg + (l * 4 + 2) * DM, modl + 3 * 1024, modl + 4 * 1024, HX, M_l};
            rowop_phase(P, gw, ngw, lane);
        } SEAM(pb + 1);
        if (IN(pb + 2) && EN(6)) REP(6) { FRESH(); EpiSwiGLU E{(bf16_t*)(ws + OFF_BIG), FH}; run_gemm(lds, HX, DM, (const bf16_t*)(ws + W_13) + (size_t)l * 5632 * 1024, M_l, 5632, DM, E); } SEAM(pb + 2);
        if (IN(pb + 3) && EN(7)) REP(7) { FRESH(); EpiF32 E{Y, DM}; run_gemm(lds, (const bf16_t*)(ws + OFF_BIG), FH, (const bf16_t*)(ws + W_2) + (size_t)l * 1024 * FH, M_l, DM, FH, E); } SEAM(pb + 3);
        if (IN(pb + 4) && EN(8)) REP(8) {
            FRESH(); const float* modl = mod + (size_t)l * 3 * 6144; const float* mod1 = mod + (size_t)3 * 6144;
            RowOp P{A.out, XSC, Y, normg + (l * 4 + 3) * DM, modl + 5 * 1024, A.out, l == 0 ? XSC : nullptr,
                    normg + 4 * DM, mod1 + 0 * 1024, mod1 + 1 * 1024, l == 0 ? HX : nullptr, M_l};
            rowop_phase(P, gw, ngw, lane);
        }
        if (l == 0) SEAM(8);
    }
#undef IN
#undef SEAM
#undef FRESH
}

extern "C" void kernel_launch(void* const* d_in, const int* in_sizes, int n_in, void* d_out, int out_size, void* d_ws, size_t ws_size, hipStream_t stream) {
    static int grid = 0;
    if (grid == 0) {
        if (n_in != 20 || in_sizes[0] != RL * DM || out_size != RL * DM || ws_size < WS_END) { fprintf(stderr, "kernel_launch: unexpected shapes (n_in %d, in0 %d, out %d, ws %zu)\n", n_in, n_in > 0 ? in_sizes[0] : -1, out_size, ws_size); grid = -1; return; }
        int dev = 0, cus = 0, per_cu = 0;
        if (hipGetDevice(&dev) != hipSuccess || hipDeviceGetAttribute(&cus, hipDeviceAttributeMultiprocessorCount, dev) != hipSuccess) { grid = -1; return; }
        if (hipFuncSetAttribute((const void*)dit_fwd, hipFuncAttributeMaxDynamicSharedMemorySize, LDS_BYTES) != hipSuccess) { fprintf(stderr, "kernel_launch: hipFuncSetAttribute failed\n"); grid = -1; return; }
        if (hipOccupancyMaxActiveBlocksPerMultiprocessor(&per_cu, (const void*)dit_fwd, NTHR, LDS_BYTES) != hipSuccess || per_cu < 1) { fprintf(stderr, "kernel_launch: occupancy query says %d\n", per_cu); per_cu = 1; }
        (void)hipGetLastError();
        grid = cus * per_cu;
    }
    if (grid < 0) return;
    Args a{};
    for (int i = 0; i < 20; ++i) a.in[i] = (const float*)d_in[i];
    a.out = (float*)d_out; a.ws = (unsigned char*)d_ws;
#if MK_PER_PHASE
    for (int p = 0; p < N_PHASES; ++p) { a.ph_lo = p; a.ph_hi = p + 1; hipLaunchKernelGGL(dit_fwd, dim3(grid), dim3(NTHR), LDS_BYTES, stream, a); }
#else
    a.ph_lo = 0; a.ph_hi = N_PHASES;
    void* args[] = {&a};
    hipError_t e = hipLaunchCooperativeKernel((const void*)dit_fwd, dim3(grid), dim3(NTHR), args, LDS_BYTES, stream);
    if (e != hipSuccess) fprintf(stderr, "cooperative launch failed: %s (grid %d)\n", hipGetErrorString(e), grid);
#endif
}
```

```cpp
#include <hip/hip_runtime.h>
#include <hip/hip_cooperative_groups.h>
#include <cstdio>
#include <cstdint>
namespace cg = cooperative_groups;
#ifndef MK_PER_PHASE
#define MK_PER_PHASE 0
#endif
namespace pg8 {
#define PG8_LAS __attribute__((address_space(3)))
typedef unsigned short bf16_t;
typedef short bf16x8 __attribute__((ext_vector_type(8)));
typedef float f32x4 __attribute__((ext_vector_type(4)));
typedef unsigned u32x4 __attribute__((ext_vector_type(4)));
constexpr int BM = 256, BK = 64, HALF = 128, HTB = HALF * BK * 2  , STAGE_BYTES = 8 * HTB, NXCD = 8, WGM = 8;

__host__ __device__ __forceinline__ int lds_byte(int r, int c) { const int st = (r >> 4) * 2 + (c >> 5), rr = r & 15, cc = c & 31, ob = rr * 64 + cc * 2; return st * 1024 + (ob ^ (((ob >> 9) & 1) << 5)); }
__host__ __device__ __forceinline__ void stage_rc(int b, int& R, int& C) { const int st = b / 1024, sb = b % 1024, swz = sb ^ (((sb >> 9) & 1) << 5); R = (st >> 1) * 16 + swz / 64; C = (st & 1) * 32 + (swz % 64) / 2; }
__host__ __device__ __forceinline__ int perm32(int rho) { const int n = rho >> 4, i = rho & 15; return 8 * (i >> 2) + 4 * n + (i & 3); }

struct Unit { int pm, pn; };
struct Gemm { const bf16_t* A; const bf16_t* Bt; int M, N, K, lda; };

struct StaticOrder {
    int nM, nN, nwg, G, c;
    __host__ __device__ void init(int M, int N, int G_, int c_) { nM = M / BM; nN = N / BM; nwg = nM * nN; G = G_; c = c_; }
    __host__ __device__ bool next(int i, Unit& u) const {
        const long L = (long)i * G + c; if (L >= nwg) return false;
        int wgid = (int)L; { const int q = nwg / NXCD, r = nwg % NXCD, xcd = wgid % NXCD, off = wgid / NXCD; wgid = (xcd < r ? xcd * (q + 1) : r * (q + 1) + (xcd - r) * q) + off; }
        const int nig = WGM * nN, gid = wgid / nig, fm = gid * WGM, gsz = (nM - fm) < WGM ? (nM - fm) : WGM;
        u.pm = fm + ((wgid % nig) % gsz); u.pn = (wgid % nig) / gsz; return true;
    }
    __device__ __forceinline__ void a_ready(const Unit&) const {}
    __device__ __forceinline__ void done(const Unit&) const {}
};


__device__ __forceinline__ unsigned cvt_pk_bf16(float lo, float hi) { unsigned r; asm volatile("v_cvt_pk_bf16_f32 %0, %1, %2" : "=v"(r) : "v"(lo), "v"(hi)); return r; }
typedef float f32x2 __attribute__((ext_vector_type(2)));

template <class Epi, class Sched, bool ALIGN_EPI = false, bool SP2 = false>
__device__ __forceinline__ void gemm_phase(PG8_LAS unsigned char* lds, const Gemm g, const Sched& S, const Epi& E) {
    int tid_ = threadIdx.x; asm volatile("" : "+v"(tid_));
    const int tid = tid_, wid = __builtin_amdgcn_readfirstlane(tid >> 6), lane = tid & 63, wr = wid >> 2, wc = wid & 3, fr = lane & 15, fq = lane >> 4;
    const int K = g.K, nt = K / BK;
    unsigned voffA[2], voffB[2];
#pragma unroll
    for (int i = 0; i < 2; ++i) { int R, C; stage_rc(tid * 16 + i * 8192, R, C); const int Rb = Epi::PERM ? ((R & ~31) + perm32(R & 31)) : R;
        voffA[i] = (unsigned)(R * g.lda + C) * 2u; voffB[i] = (unsigned)(Rb * K + C) * 2u; }
    const size_t kstep = (size_t)(BK * 2);
    const size_t hstep = (size_t)HALF * K * 2;
    const size_t tstep = 2 * hstep; const size_t hstepA = (size_t)HALF * g.lda * 2, tstepA = 2 * hstepA;
    const unsigned ldsw = (unsigned)wid * 1024u;
    const int aoff = lds_byte(wr * 64 + fr, fq * 8), boff = lds_byte(wc * 32 + fr, fq * 8);
#define PG8_SA(b, h) (((b) * 2 + (h)) * HTB)
#define PG8_SB(b, h) ((4 + (b) * 2 + (h)) * HTB)
#define PG8_STAGE(bufoff, gbase, voff) do { _Pragma("unroll") for (int _i = 0; _i < 2; ++_i) \
        __builtin_amdgcn_global_load_lds((const unsigned*)((const char*)(gbase) + (voff)[_i]), (PG8_LAS unsigned*)(lds + (bufoff) + ldsw + _i * 8192), 16, 0, 0); } while (0)
#define PG8_LDA(dst, b, h) do { _Pragma("unroll") for (int m = 0; m < 4; ++m) _Pragma("unroll") for (int k = 0; k < 2; ++k) dst[m][k] = *(const PG8_LAS bf16x8*)(lds + PG8_SA(b, h) + aoff + m * 2048 + k * 1024); } while (0)
#define PG8_LDB(dst, b, h) do { _Pragma("unroll") for (int n = 0; n < 2; ++n) _Pragma("unroll") for (int k = 0; k < 2; ++k) dst[n][k] = *(const PG8_LAS bf16x8*)(lds + PG8_SB(b, h) + boff + n * 2048 + k * 1024); } while (0)
#define PG8_MMA(ai, bj, At, Bt) do { __builtin_amdgcn_s_setprio(1); _Pragma("unroll") for (int m = 0; m < 4; ++m) _Pragma("unroll") for (int n = 0; n < 2; ++n) _Pragma("unroll") for (int k = 0; k < 2; ++k) \
        acc[ai][bj][m][n] = __builtin_amdgcn_mfma_f32_16x16x32_bf16(Bt[n][k], At[m][k], acc[ai][bj][m][n], 0, 0, 0); __builtin_amdgcn_s_setprio(0); } while (0)
#define PG8_WAIT_V(n) asm volatile("s_waitcnt vmcnt(" #n ")" ::: "memory")
#define PG8_WAIT_L(n) asm volatile("s_waitcnt lgkmcnt(" #n ")" ::: "memory")
#define PG8_BAR __builtin_amdgcn_s_barrier()
#define PG8_SCHED __builtin_amdgcn_sched_barrier(0)
    Unit cur, nxt; int ui = 0;
    if (!S.next(0, cur)) return;
    f32x4 acc[2][2][4][2];
#pragma unroll
    for (int a = 0; a < 2; ++a)
#pragma unroll
        for (int b = 0; b < 2; ++b)
#pragma unroll
            for (int m = 0; m < 4; ++m)
#pragma unroll
                for (int n = 0; n < 2; ++n) acc[a][b][m][n] = (f32x4){0.f, 0.f, 0.f, 0.f};
    bf16x8 At[4][2], B0[2][2], B1[2][2];
    const char* cA = (const char*)g.A + (size_t)cur.pm * tstepA; const char* cB = (const char*)g.Bt + (size_t)cur.pn * tstep;
    S.a_ready(cur);
    if constexpr (SP2) {
        PG8_STAGE(PG8_SB(0, 0), cB, voffB); PG8_STAGE(PG8_SB(0, 1), cB + hstep, voffB); PG8_STAGE(PG8_SA(0, 0), cA, voffA); PG8_STAGE(PG8_SA(0, 1), cA + hstepA, voffA);
        if (wr == 1) PG8_BAR;
        PG8_WAIT_V(2); PG8_BAR;
        PG8_STAGE(PG8_SB(1, 0), cB + kstep, voffB); PG8_STAGE(PG8_SA(1, 0), cA + kstep, voffA); PG8_STAGE(PG8_SB(1, 1), cB + hstep + kstep, voffB);
        PG8_WAIT_V(6); PG8_BAR;
    } else {
        PG8_STAGE(PG8_SB(0, 0), cB, voffB); PG8_STAGE(PG8_SA(0, 0), cA, voffA); PG8_STAGE(PG8_SB(0, 1), cB + hstep, voffB); PG8_STAGE(PG8_SA(0, 1), cA + hstepA, voffA);
        if (wr == 1) PG8_BAR;
        PG8_WAIT_V(4); PG8_BAR;
        PG8_STAGE(PG8_SB(1, 0), cB + kstep, voffB); PG8_STAGE(PG8_SA(1, 0), cA + kstep, voffA); PG8_STAGE(PG8_SB(1, 1), cB + hstep + kstep, voffB);
        PG8_WAIT_V(6); PG8_BAR;
    }
    for (;;) {
        const bool has_next = S.next(ui + 1, nxt);
        const char* nA = has_next ? (const char*)g.A + (size_t)nxt.pm * tstepA : cA; const char* nB = has_next ? (const char*)g.Bt + (size_t)nxt.pn * tstep : cB;
        for (int t = 0; t < nt; t += 2) {
            const bool last = (t == nt - 2);
            const char* a1 = cA + (size_t)(t + 1) * kstep;
            const char* a2 = last ? nA : cA + (size_t)(t + 2) * kstep; const char* b2 = last ? nB : cB + (size_t)(t + 2) * kstep;
            const char* a3 = a2 + kstep; const char* b3 = b2 + kstep;
            if (last && has_next) S.a_ready(nxt);
            if constexpr (SP2) {
            PG8_LDB(B0, 0, 0); PG8_LDB(B1, 0, 1); PG8_SCHED; PG8_LDA(At, 0, 0); PG8_STAGE(PG8_SA(1, 1), a1 + hstepA, voffA);
            PG8_WAIT_V(8); PG8_WAIT_L(0); PG8_BAR; PG8_MMA(0, 0, At, B0); PG8_MMA(0, 1, At, B1); PG8_BAR; PG8_SCHED;
            PG8_LDA(At, 0, 1); PG8_STAGE(PG8_SB(0, 0), b2, voffB); PG8_STAGE(PG8_SB(0, 1), b2 + hstep, voffB); PG8_STAGE(PG8_SA(0, 0), a2, voffA);
            PG8_WAIT_V(8); PG8_WAIT_L(0); PG8_BAR; PG8_MMA(1, 0, At, B0); PG8_MMA(1, 1, At, B1); PG8_BAR; PG8_SCHED;
            PG8_LDB(B0, 1, 0); PG8_LDB(B1, 1, 1); PG8_SCHED; PG8_LDA(At, 1, 0); PG8_STAGE(PG8_SA(0, 1), a2 + hstepA, voffA);
            PG8_WAIT_V(8); PG8_WAIT_L(0); PG8_BAR; PG8_MMA(0, 0, At, B0); PG8_MMA(0, 1, At, B1); PG8_BAR; PG8_SCHED;
            PG8_LDA(At, 1, 1); PG8_STAGE(PG8_SB(1, 0), b3, voffB); PG8_STAGE(PG8_SB(1, 1), b3 + hstep, voffB); PG8_STAGE(PG8_SA(1, 0), a3, voffA);
            PG8_WAIT_V(8); PG8_WAIT_L(0); PG8_BAR; PG8_MMA(1, 0, At, B0); PG8_MMA(1, 1, At, B1); PG8_BAR; PG8_SCHED;
            } else {
            PG8_LDB(B0, 0, 0); PG8_SCHED; PG8_LDA(At, 0, 0); PG8_STAGE(PG8_SA(1, 1), a1 + hstepA, voffA);
            PG8_WAIT_L(8); PG8_BAR; PG8_WAIT_L(0); PG8_MMA(0, 0, At, B0); PG8_BAR; PG8_SCHED;
            PG8_LDB(B1, 0, 1); PG8_STAGE(PG8_SB(0, 0), b2, voffB);
            PG8_BAR; PG8_WAIT_L(0); PG8_MMA(0, 1, At, B1); PG8_BAR;
            PG8_LDA(At, 0, 1); PG8_STAGE(PG8_SA(0, 0), a2, voffA);
            PG8_BAR; PG8_WAIT_L(0); PG8_MMA(1, 0, At, B0); PG8_BAR; PG8_SCHED;
            PG8_STAGE(PG8_SB(0, 1), b2 + hstep, voffB);
            PG8_WAIT_V(6); PG8_BAR; PG8_MMA(1, 1, At, B1); PG8_BAR;
            PG8_LDB(B0, 1, 0); PG8_SCHED; PG8_LDA(At, 1, 0); PG8_STAGE(PG8_SA(0, 1), a2 + hstepA, voffA);
            PG8_WAIT_L(8); PG8_BAR; PG8_WAIT_L(0); PG8_MMA(0, 0, At, B0); PG8_BAR; PG8_SCHED;
            PG8_LDB(B1, 1, 1); PG8_STAGE(PG8_SB(1, 0), b3, voffB);
            PG8_BAR; PG8_WAIT_L(0); PG8_MMA(0, 1, At, B1); PG8_BAR;
            PG8_LDA(At, 1, 1); PG8_STAGE(PG8_SA(1, 0), a3, voffA);
            PG8_BAR; PG8_WAIT_L(0); PG8_MMA(1, 0, At, B0); PG8_BAR; PG8_SCHED;
            PG8_STAGE(PG8_SB(1, 1), b3 + hstep, voffB);
            PG8_WAIT_V(6); PG8_BAR; PG8_MMA(1, 1, At, B1); PG8_BAR;
            }
        }
        if constexpr (ALIGN_EPI) { if (wr == 0) PG8_BAR; }
        if constexpr (!Epi::AFTER_DRAIN) { E(acc, cur, wr, wc, fr, fq); S.done(cur); }
        if (!has_next) break;
#pragma unroll
        for (int a = 0; a < 2; ++a)
#pragma unroll
            for (int b = 0; b < 2; ++b)
#pragma unroll
                for (int m = 0; m < 4; ++m)
#pragma unroll
                    for (int n = 0; n < 2; ++n) acc[a][b][m][n] = (f32x4){0.f, 0.f, 0.f, 0.f};
        cur = nxt; cA = nA; cB = nB; ++ui;
        if constexpr (ALIGN_EPI) { if (wr == 1) PG8_BAR; }
    }
    PG8_WAIT_V(0);
    if constexpr (!ALIGN_EPI) { if (wr == 0) PG8_BAR; }
    PG8_BAR;
    if constexpr (Epi::AFTER_DRAIN) { E.fused(acc, cur, wr, wc, fr, fq, lds, wid, lane); S.done(cur); }
#undef PG8_SA
#undef PG8_SB
#undef PG8_STAGE
#undef PG8_LDA
#undef PG8_LDB
#undef PG8_MMA
#undef PG8_WAIT_V
#undef PG8_WAIT_L
#undef PG8_BAR
#undef PG8_SCHED
}
}

#define DI __device__ __forceinline__
typedef pg8::bf16_t bf16_t;
typedef pg8::f32x4 f32x4;
typedef pg8::u32x4 u32x4;
typedef unsigned u32x2 __attribute__((ext_vector_type(2)));
#define LAS __attribute__((address_space(3)))

constexpr int DM = 1024, SEQ = 8192, NBATCH = 2, CTXL = 256;
constexpr int RL = NBATCH * SEQ;
constexpr int RT = RL + NBATCH * CTXL;
constexpr int FH = 2816, ABW = 2304;
constexpr float EPS = 1e-6f, LOG2E = 1.4426950408889634f;
constexpr int NWAVES = 8, NTHR = 512;
constexpr int LDS_BYTES = 147456;

constexpr size_t MiB = 1u << 20;
constexpr size_t OFF_MOD = 0;
constexpr size_t OFF_TAB_AB = 147456;
constexpr size_t OFF_TAB_C = 163840;
constexpr size_t OFF_BAR = 196608;
constexpr size_t OFF_KR = 1 * MiB;
constexpr size_t OFF_XSC = 3 * MiB;
constexpr size_t OFF_W = 5 * MiB;
constexpr size_t W_ABIN = OFF_W;
constexpr size_t W_ABOUT = W_ABIN + (size_t)2304 * 1024 * 2;
constexpr size_t W_13 = W_ABOUT + (size_t)1024 * 1024 * 2;
constexpr size_t W_2 = W_13 + (size_t)2 * 5632 * 1024 * 2;
constexpr size_t W_MIN = W_2 + (size_t)2 * 1024 * 2816 * 2;
constexpr size_t W_QB = W_MIN + (size_t)768 * 1024 * 2;
constexpr size_t W_KVB = W_QB + (size_t)1536 * 384 * 2;
constexpr size_t W_MOUT = W_KVB + (size_t)2048 * 256 * 2;
constexpr size_t W_END = W_MOUT + (size_t)1024 * 1024 * 2;
constexpr size_t OFF_HXR = 52 * MiB;
constexpr size_t OFF_YR = 85 * MiB;
constexpr size_t OFF_BIG = 151 * MiB;
constexpr size_t WS_END = OFF_BIG + (size_t)RT * FH * 2;
static_assert(W_END <= OFF_HXR && WS_END <= 256 * MiB, "ws map");
constexpr size_t OFF_QL = OFF_HXR, OFF_KVL = OFF_HXR + (size_t)RT * 384 * 2;

#define XB_TMO      128
#define XB_XCNT(j)  (256  + 64 * (j))
#define XB_XSUB(j)  (1280 + 64 * (j))
#define XB_XGEN(j)  (2304 + 64 * (j))
#define XB_TOP      3328
#define XB_TOPGEN   3392
#define XCD_BAR_WORDS 3456
#define XB_SPIN_CAP (1u << 18)

__device__ __forceinline__ unsigned xb_ld(unsigned* p)              { return __hip_atomic_load(p, __ATOMIC_RELAXED, __HIP_MEMORY_SCOPE_AGENT); }
__device__ __forceinline__ unsigned xb_add(unsigned* p, unsigned v) { return __hip_atomic_fetch_add(p, v, __ATOMIC_RELAXED, __HIP_MEMORY_SCOPE_AGENT); }
__device__ __forceinline__ unsigned xb_xcc_id() { return (unsigned)__builtin_amdgcn_s_getreg((3 << 11) | 20) & 0xFu; }
#define XB_SPIN(cond, bar) do { unsigned _sp = 0; while (cond) { __builtin_amdgcn_s_sleep(1); \
    if ((++_sp & 255u) == 0u) { if (xb_ld(&(bar)[XB_TMO])) break; if (_sp > XB_SPIN_CAP) { atomicAdd(&(bar)[XB_TMO], 1u); break; } } } } while (0)

struct XcdBarrier {
    unsigned* bar; unsigned x;
    volatile LAS unsigned* st;
};

__device__ __forceinline__ XcdBarrier xcd_barrier_post(unsigned* bar, volatile LAS unsigned* st) {
    XcdBarrier b; b.bar = bar; b.x = xb_xcc_id(); b.st = st;
    if (threadIdx.x == 0) (void)xb_add(&bar[XB_XCNT(b.x)], 1u);
    return b;
}
__device__ __forceinline__ void xcd_barrier_complete(unsigned* bar, unsigned x, unsigned& nloc, unsigned& nx) {
    const unsigned G = gridDim.x * gridDim.y * gridDim.z;
    unsigned sum, cnt, mine, sp = 0u;
    for (;;) {
        sum = 0u; cnt = 0u; mine = 0u;
#pragma unroll
        for (unsigned j = 0; j < 16; ++j) { const unsigned c = xb_ld(&bar[XB_XCNT(j)]); sum += c; cnt += (c > 0u) ? 1u : 0u; mine = (j == x) ? c : mine; }
        if (sum == G) break;
        __builtin_amdgcn_s_sleep(1);
        if ((++sp & 255u) == 0u) { if (xb_ld(&bar[XB_TMO])) break; if (sp > XB_SPIN_CAP) { atomicAdd(&bar[XB_TMO], 1u); break; } }
    }
    nloc = mine > 0u ? mine : 1u; nx = cnt > 0u ? cnt : 1u;
}

__device__ __forceinline__ void xcd_barrier(const XcdBarrier& b) {
    asm volatile("s_waitcnt vmcnt(0)" ::: "memory");
    __syncthreads();
    if (threadIdx.x == 0) {
        unsigned* bar = b.bar;
        __builtin_amdgcn_s_waitcnt(0);
        unsigned nloc = b.st[0], nx = b.st[1];
        if (nloc == 0u) { xcd_barrier_complete(bar, b.x, nloc, nx); b.st[0] = nloc; b.st[1] = nx; }
        const unsigned old = xb_add(&bar[XB_XSUB(b.x)], 1u);
        const unsigned gen = old / nloc;
        if (old + 1u == (gen + 1u) * nloc) {
            __builtin_amdgcn_fence(__ATOMIC_RELEASE, "agent");
            asm volatile("s_waitcnt vmcnt(0)" ::: "memory");
            const unsigned og = xb_add(&bar[XB_TOP], 1u);
            const unsigned tg = og / nx;
            if (og + 1u == (tg + 1u) * nx) xb_add(&bar[XB_TOPGEN], 1u);
            else XB_SPIN(xb_ld(&bar[XB_TOPGEN]) == tg, bar);
            __builtin_amdgcn_fence(__ATOMIC_ACQUIRE, "agent");
            xb_add(&bar[XB_XGEN(b.x)], 1u);
            asm volatile("s_waitcnt vmcnt(0)" ::: "memory");
        } else {
            XB_SPIN(xb_ld(&bar[XB_XGEN(b.x)]) == gen, bar);
            __builtin_amdgcn_fence(__ATOMIC_ACQUIRE, "agent");
            asm volatile("s_waitcnt vmcnt(0)" ::: "memory");
        }
    }
    __syncthreads();
}

constexpr int LDS_ST_OFF = 131072 + 512;

struct EpiF32 {
    static constexpr bool PERM = false, AFTER_DRAIN = false;
    float* O; int ldc;
    DI void operator()(const f32x4 (&acc)[2][2][4][2], const pg8::Unit& u, int wr, int wc, int fr_, int fq_) const {
        int fr = fr_, fq = fq_; asm volatile("" : "+v"(fr), "+v"(fq));
        const int row0 = u.pm * 256 + wr * 64 + fr, col0 = u.pn * 256 + wc * 32 + 4 * fq;
#pragma unroll
        for (int ai = 0; ai < 2; ++ai)
#pragma unroll
            for (int m = 0; m < 4; ++m) { float* rowp = O + (size_t)(row0 + ai * 128 + m * 16) * ldc + col0;
#pragma unroll
                for (int bj = 0; bj < 2; ++bj)
#pragma unroll
                    for (int n = 0; n < 2; ++n) *(f32x4*)(rowp + bj * 128 + n * 16) = acc[ai][bj][m][n]; }
    }
};
struct EpiBf16P {
    static constexpr bool PERM = true, AFTER_DRAIN = false;
    bf16_t* O; int ldc;
    DI void operator()(const f32x4 (&acc)[2][2][4][2], const pg8::Unit& u, int wr, int wc, int fr_, int fq_) const {
        int fr = fr_, fq = fq_; asm volatile("" : "+v"(fr), "+v"(fq));
        const int row0 = u.pm * 256 + wr * 64 + fr, col0 = u.pn * 256 + wc * 32 + 8 * fq;
#pragma unroll
        for (int ai = 0; ai < 2; ++ai)
#pragma unroll
            for (int m = 0; m < 4; ++m) { bf16_t* rowp = O + (size_t)(row0 + ai * 128 + m * 16) * ldc + col0;
#pragma unroll
                for (int bj = 0; bj < 2; ++bj) { const f32x4 v0 = acc[ai][bj][m][0], v1 = acc[ai][bj][m][1]; u32x4 w;
                    w.x = pg8::cvt_pk_bf16(v0[0], v0[1]); w.y = pg8::cvt_pk_bf16(v0[2], v0[3]); w.z = pg8::cvt_pk_bf16(v1[0], v1[1]); w.w = pg8::cvt_pk_bf16(v1[2], v1[3]);
                    *(u32x4*)(rowp + bj * 128) = w; } }
    }
};
DI float silu_f(float g) { return g / (1.0f + __expf(-g)); }
struct EpiSwiGLU {
    static constexpr bool PERM = true, AFTER_DRAIN = false;
    bf16_t* O; int ldc;
    DI void operator()(const f32x4 (&acc)[2][2][4][2], const pg8::Unit& u, int wr, int wc, int fr_, int fq_) const {
        int fr = fr_, fq = fq_; asm volatile("" : "+v"(fr), "+v"(fq));
        const int row0 = u.pm * 256 + wr * 64 + fr, col0 = u.pn * 128 + wc * 32 + 8 * fq;
#pragma unroll
        for (int ai = 0; ai < 2; ++ai)
#pragma unroll
            for (int m = 0; m < 4; ++m) { bf16_t* rowp = O + (size_t)(row0 + ai * 128 + m * 16) * ldc + col0;
                const f32x4 g0 = acc[ai][0][m][0], g1 = acc[ai][0][m][1], u0 = acc[ai][1][m][0], u1 = acc[ai][1][m][1]; u32x4 w;
                w.x = pg8::cvt_pk_bf16(silu_f(g0[0]) * u0[0], silu_f(g0[1]) * u0[1]); w.y = pg8::cvt_pk_bf16(silu_f(g0[2]) * u0[2], silu_f(g0[3]) * u0[3]);
                w.z = pg8::cvt_pk_bf16(silu_f(g1[0]) * u1[0], silu_f(g1[1]) * u1[1]); w.w = pg8::cvt_pk_bf16(silu_f(g1[2]) * u1[2], silu_f(g1[3]) * u1[3]);
                *(u32x4*)rowp = w; }
    }
};
typedef float f32x2v __attribute__((ext_vector_type(2)));
struct EpiQKV {
    static constexpr bool PERM = false, AFTER_DRAIN = false;
    bf16_t* O; const float* tab;
    DI void operator()(const f32x4 (&acc)[2][2][4][2], const pg8::Unit& u, int wr, int wc, int fr_, int fq_) const {
        int fr = fr_, fq = fq_; asm volatile("" : "+v"(fr), "+v"(fq));
        const int row0 = u.pm * 256 + wr * 64 + fr;
#pragma unroll
        for (int bj = 0; bj < 2; ++bj) {
            const int cb = u.pn * 256 + bj * 128;
            const bool rope = (cb < 1152) || (cb >= 1280 && cb < 1792);
            const float sc = cb < 1024 ? 0.125f * LOG2E : 1.0f;
#pragma unroll
            for (int ai = 0; ai < 2; ++ai)
#pragma unroll
                for (int m = 0; m < 4; ++m) {
                    const int row = row0 + ai * 128 + m * 16;
                    f32x4 v0 = acc[ai][bj][m][0], v1 = acc[ai][bj][m][1];
                    if (rope && row < RL) {
                        const int t = row & (SEQ - 1), pos = (wc & 1) ? (t & 63) : (t >> 6);
                        const float* tp = tab + (size_t)(pos * 16 + 4 * fq) * 2;
                        const f32x4 cs01 = *(const f32x4*)tp, cs23 = *(const f32x4*)(tp + 4);
                        const f32x4 cs = {cs01[0], cs01[2], cs23[0], cs23[2]}, sn = {cs01[1], cs01[3], cs23[1], cs23[3]};
                        const f32x4 o0 = v0 * cs - v1 * sn, o1 = v1 * cs + v0 * sn; v0 = o0; v1 = o1;
                    }
                    v0 = v0 * sc; v1 = v1 * sc;
                    bf16_t* p = O + (size_t)row * ABW + cb + wc * 32 + 4 * fq;
                    u32x2 w0, w1; w0.x = pg8::cvt_pk_bf16(v0[0], v0[1]); w0.y = pg8::cvt_pk_bf16(v0[2], v0[3]); w1.x = pg8::cvt_pk_bf16(v1[0], v1[1]); w1.y = pg8::cvt_pk_bf16(v1[2], v1[3]);
                    *(u32x2*)p = w0; *(u32x2*)(p + 16) = w1;
                }
        }
    }
};
struct EpiMlaQ {
    static constexpr bool PERM = false, AFTER_DRAIN = false;
    bf16_t* O; const float* tab;
    DI void operator()(const f32x4 (&acc)[2][2][4][2], const pg8::Unit& u, int wr, int wc, int fr_, int fq_) const {
        int fr = fr_, fq = fq_; asm volatile("" : "+v"(fr), "+v"(fq));
        const int row0 = u.pm * 256 + wr * 64 + fr;
        const float sc = 0.10206207261596575f * LOG2E;
#pragma unroll
        for (int bj = 0; bj < 2; ++bj) {
            const int cb = u.pn * 256 + bj * 128, G = (cb >> 5) + wc;
            const bool rope = (G % 3) == 2;
#pragma unroll
            for (int ai = 0; ai < 2; ++ai)
#pragma unroll
                for (int m = 0; m < 4; ++m) {
                    const int row = row0 + ai * 128 + m * 16;
                    f32x4 v0 = acc[ai][bj][m][0], v1 = acc[ai][bj][m][1];
                    if (rope) {
                        const int t = row & (SEQ - 1), pos = (fq & 2) ? (t & 63) : (t >> 6);
                        const float* tp = tab + (size_t)(pos * 8 + 4 * (fq & 1)) * 2;
                        const f32x4 cs01 = *(const f32x4*)tp, cs23 = *(const f32x4*)(tp + 4);
                        const f32x4 cs = {cs01[0], cs01[2], cs23[0], cs23[2]}, sn = {cs01[1], cs01[3], cs23[1], cs23[3]};
                        const f32x4 o0 = v0 * cs - v1 * sn, o1 = v1 * cs + v0 * sn; v0 = o0; v1 = o1;
                    }
                    v0 = v0 * sc; v1 = v1 * sc;
                    bf16_t* p = O + (size_t)row * 1536 + cb + wc * 32 + 4 * fq;
                    u32x2 w0, w1; w0.x = pg8::cvt_pk_bf16(v0[0], v0[1]); w0.y = pg8::cvt_pk_bf16(v0[2], v0[3]); w1.x = pg8::cvt_pk_bf16(v1[0], v1[1]); w1.y = pg8::cvt_pk_bf16(v1[2], v1[3]);
                    *(u32x2*)p = w0; *(u32x2*)(p + 16) = w1;
                }
        }
    }
};

template <class Epi>
DI void run_gemm(LAS unsigned char* lds, const bf16_t* A, int lda, const bf16_t* Bt, int M, int N, int K, const Epi& E) {
    int bx_ = blockIdx.x; asm volatile("" : "+s"(bx_));
    asm volatile("" : "+s"(M), "+s"(N), "+s"(K), "+s"(lda));
    pg8::Gemm g{A, Bt, M, N, K, lda}; pg8::StaticOrder S; S.init(M, N, (int)gridDim.x, bx_);
    pg8::gemm_phase<Epi, pg8::StaticOrder, true, true>(lds, g, S, E);
}

namespace att {
using bf16x8 = __attribute__((ext_vector_type(8))) short;
using s16x4 = __attribute__((ext_vector_type(4))) short;
using f32x16 = __attribute__((ext_vector_type(16))) float;
#define SBAR() __builtin_amdgcn_sched_barrier(0)
#define LBAR() asm volatile("s_waitcnt lgkmcnt(0)\n\ts_barrier" ::: "memory")
constexpr float THR = 11.5f, NEGBIG = -1e30f;
DI int crow(int r, int hi) { return (r & 3) + 8 * (r >> 2) + 4 * hi; }
DI unsigned cvtpk(float lo, float hi) { unsigned r; asm volatile("v_cvt_pk_bf16_f32 %0, %1, %2" : "=v"(r) : "v"(lo), "v"(hi)); return r; }
DI int kswz64(int row, int colB) { return row * 128 + (colB ^ (((row >> 1) & 7) << 4)); }
DI int kswz32(int row, int chunk) { return row * 64 + ((chunk ^ ((row >> 2) & 3)) << 4); }

DI void partialSM(f32x16& p0, f32x16& p1, float& m_reg, float& mn, float& alpha) {
    float pmax = p0[0];
#pragma unroll
    for (int r = 1; r < 16; ++r) pmax = fmaxf(pmax, p0[r]);
#pragma unroll
    for (int r = 0; r < 16; ++r) pmax = fmaxf(pmax, p1[r]);
    { auto rr = __builtin_amdgcn_permlane32_swap(__float_as_uint(pmax), __float_as_uint(pmax), false, false);
      pmax = fmaxf(__uint_as_float(rr[0]), __uint_as_float(rr[1])); }
    if (__builtin_expect(__all(pmax - m_reg <= THR), 1)) { mn = m_reg; alpha = 1.f; }
    else { mn = fmaxf(m_reg, pmax); alpha = __builtin_amdgcn_exp2f(m_reg - mn); m_reg = mn; }
#pragma unroll
    for (int r = 0; r < 16; ++r) { p0[r] = p0[r] - mn; p1[r] = p1[r] - mn; }
#pragma unroll
    for (int r = 0; r < 16; ++r) p0[r] = __builtin_amdgcn_exp2f(p0[r]);
}
DI void finishSM(f32x16& p0, f32x16& p1, float alpha, float& l_reg, bf16x8& pa0, bf16x8& pa1, bf16x8& pa2, bf16x8& pa3) {
#pragma unroll
    for (int r = 0; r < 16; ++r) p1[r] = __builtin_amdgcn_exp2f(p1[r]);
    float ps = 0;
#pragma unroll
    for (int r = 0; r < 16; ++r) ps += p0[r];
#pragma unroll
    for (int r = 0; r < 16; ++r) ps += p1[r];
    { auto rr = __builtin_amdgcn_permlane32_swap(__float_as_uint(ps), __float_as_uint(ps), false, false);
      ps = __uint_as_float(rr[0]) + __uint_as_float(rr[1]); }
    l_reg = l_reg * alpha + ps;
#define PK4(P, BASE, OUT) do { unsigned a0 = cvtpk(P[BASE + 0], P[BASE + 1]), a1 = cvtpk(P[BASE + 2], P[BASE + 3]);   \
    unsigned b0 = cvtpk(P[BASE + 4], P[BASE + 5]), b1 = cvtpk(P[BASE + 6], P[BASE + 7]);                              \
    auto r0 = __builtin_amdgcn_permlane32_swap(a0, b0, false, false); auto r1 = __builtin_amdgcn_permlane32_swap(a1, b1, false, false); \
    u32x4 w = {r0[0], r1[0], r0[1], r1[1]}; OUT = __builtin_bit_cast(bf16x8, w); } while (0)
    PK4(p0, 0, pa0); PK4(p0, 8, pa1); PK4(p1, 0, pa2); PK4(p1, 8, pa3);
#undef PK4
}
template <int DK2>
DI void qkt(f32x16& p0, f32x16& p1, const char* K1b, const char* K2b, const bf16x8* qr, int r32, int hi) {
    p0 = f32x16{}; p1 = f32x16{};
#pragma unroll
    for (int d0 = 0; d0 < 4; ++d0) { const int cb = d0 * 32 + hi * 16;
        const bf16x8 b0 = *reinterpret_cast<const bf16x8*>(K1b + kswz64(r32, cb));
        const bf16x8 b1 = *reinterpret_cast<const bf16x8*>(K1b + kswz64(32 + r32, cb));
        p0 = __builtin_amdgcn_mfma_f32_32x32x16_bf16(b0, qr[d0], p0, 0, 0, 0);
        p1 = __builtin_amdgcn_mfma_f32_32x32x16_bf16(b1, qr[d0], p1, 0, 0, 0); }
    if constexpr (DK2 > 0) {
#pragma unroll
        for (int d0 = 0; d0 < 2; ++d0) { const int ch = d0 * 2 + hi;
            const bf16x8 b0 = *reinterpret_cast<const bf16x8*>(K2b + kswz32(r32, ch));
            const bf16x8 b1 = *reinterpret_cast<const bf16x8*>(K2b + kswz32(32 + r32, ch));
            p0 = __builtin_amdgcn_mfma_f32_32x32x16_bf16(b0, qr[4 + d0], p0, 0, 0, 0);
            p1 = __builtin_amdgcn_mfma_f32_32x32x16_bf16(b1, qr[4 + d0], p1, 0, 0, 0); }
    }
}
DI void wmask(f32x16& p0, f32x16& p1, int kp, int qp, int hi) {
#pragma unroll
    for (int r = 0; r < 16; ++r) { const int d0 = kp + crow(r, hi) - qp, d1 = d0 + 32;
        if (d0 > 128 || d0 < -128) p0[r] = NEGBIG;
        if (d1 > 128 || d1 < -128) p1[r] = NEGBIG; }
}
template <int NC> DI int v_st(int k, int c) { const int kk = (k & ~0xC) | ((k & 4) << 1) | ((k & 8) >> 1); return ((kk >> 3) * NC + (c >> 5)) * 512 + ((kk & 7) * 32 + (c & 31)) * 2; }
DI int v_rd_base(int lane) { return ((lane & 3) << 3) | (((lane >> 2) & 3) << 6) | (((lane >> 4) & 1) << 5) | (((lane >> 5) & 1) << 8); }
template <int OFF> DI s16x4 tr_read(int vb) { s16x4 r; asm volatile("ds_read_b64_tr_b16 %0, %1 offset:%2" : "=&v"(r) : "v"(vb), "i"(OFF) : "memory"); return r; }
template <int NC, int D0> DI void pv_one(f32x16& od, int vb, bf16x8 pa0, bf16x8 pa1, bf16x8 pa2, bf16x8 pa3) {
    constexpr int KS = 2 * NC * 512, HF = NC * 512, B0 = D0 * 512;
    const s16x4 l0 = tr_read<B0 + 0 * KS>(vb), h0 = tr_read<B0 + 0 * KS + HF>(vb), l1 = tr_read<B0 + 1 * KS>(vb), h1 = tr_read<B0 + 1 * KS + HF>(vb);
    const s16x4 l2 = tr_read<B0 + 2 * KS>(vb), h2 = tr_read<B0 + 2 * KS + HF>(vb), l3 = tr_read<B0 + 3 * KS>(vb), h3 = tr_read<B0 + 3 * KS + HF>(vb);
    asm volatile("s_waitcnt lgkmcnt(0)" ::: "memory"); SBAR();
#define PKV(L, H) (bf16x8){L[0], L[1], L[2], L[3], H[0], H[1], H[2], H[3]}
    od = __builtin_amdgcn_mfma_f32_32x32x16_bf16(pa0, PKV(l0, h0), od, 0, 0, 0);
    od = __builtin_amdgcn_mfma_f32_32x32x16_bf16(pa1, PKV(l1, h1), od, 0, 0, 0);
    od = __builtin_amdgcn_mfma_f32_32x32x16_bf16(pa2, PKV(l2, h2), od, 0, 0, 0);
    od = __builtin_amdgcn_mfma_f32_32x32x16_bf16(pa3, PKV(l3, h3), od, 0, 0, 0);
#undef PKV
}
template <int NC> DI void pv_all(f32x16* o, int vb, bf16x8 pa0, bf16x8 pa1, bf16x8 pa2, bf16x8 pa3) {
    pv_one<NC, 0>(o[0], vb, pa0, pa1, pa2, pa3); pv_one<NC, 1>(o[1], vb, pa0, pa1, pa2, pa3);
    if constexpr (NC == 4) { pv_one<NC, 2>(o[2], vb, pa0, pa1, pa2, pa3); pv_one<NC, 3>(o[3], vb, pa0, pa1, pa2, pa3); }
}

struct Job {
    const bf16_t* Q; int ldq;
    const bf16_t* K1; int ldk1;
    const bf16_t* K2; int ldk2;
    const bf16_t* V; int ldv;
    int row1, nt1, row2, nt2;
    int win, qpos0, kpos0;
    float m0, l0;
    int omode;
    bf16_t* Ob; int ldo;
    float* Of; int ldf;
    float lam; const float* subg;
};

template <int DK2, int DV>
DI void unit(const Job& J, char* lds) {
    constexpr int NC = DV / 32, NQ = (64 + DK2) / 16;
    constexpr int KB1 = 8192, KB2 = 4096, VBY = 64 * DV * 2;
    int tid = threadIdx.x; asm volatile("" : "+v"(tid));
    const int wid = tid >> 6, lane = tid & 63, r32 = lane & 31, hi = lane >> 5;
    char* K1s = lds; char* K2s = lds + 2 * KB1; char* Vs = lds + 2 * KB1 + 2 * KB2;
    float* wsf = (float*)(lds + 2 * KB1 + 2 * KB2 + 2 * VBY) + wid * 64; float* li_l = wsf; float* al_l = wsf + 32;
    float m_reg = J.m0, l_reg = J.l0; f32x16 o[NC]; bf16x8 qr[NQ];
#pragma unroll
    for (int d = 0; d < NC; ++d) o[d] = f32x16{};
    const bf16_t* Qw = J.Q + (size_t)(wid * 32 + r32) * J.ldq + hi * 8;
#pragma unroll
    for (int d0 = 0; d0 < NQ; ++d0) qr[d0] = *reinterpret_cast<const bf16x8*>(Qw + d0 * 16);
    const int kr = tid >> 3, kc = (tid & 7) * 8;
    const int k2r = (tid >> 2) & 63, k2c = (tid & 3) * 8;
    const int vr = (DV == 64) ? (tid >> 3) : (tid >> 4), vc = (DV == 64) ? (tid & 7) * 8 : (tid & 15) * 8;
    const int k1off = kswz64(kr, kc * 2), k2off = kswz32(k2r, tid & 3);
    const int vst0 = v_st<NC>(vr, vc), vst1 = v_st<NC>(32 + vr, vc);
    const int vb0 = (int)(uintptr_t)Vs + v_rd_base(lane);
    const int NT = J.nt1 + J.nt2;
    const int qp = J.qpos0 + wid * 32 + r32;
    struct { bf16x8 k1, k2, v0, v1; } sr_[2];
#define TROW(t) ((t) < J.nt1 ? J.row1 + 64 * (t) : J.row2 + 64 * ((t) - J.nt1))
#define SLOAD(i, t) do { const size_t rw_ = (size_t)TROW(t); \
        sr_[i].k1 = *reinterpret_cast<const bf16x8*>(J.K1 + (rw_ + kr) * J.ldk1 + kc); \
        if (DK2 > 0 && tid < 256) sr_[i].k2 = *reinterpret_cast<const bf16x8*>(J.K2 + (rw_ + k2r) * J.ldk2 + k2c); \
        sr_[i].v0 = *reinterpret_cast<const bf16x8*>(J.V + (rw_ + vr) * J.ldv + vc); \
        if (DV == 128) sr_[i].v1 = *reinterpret_cast<const bf16x8*>(J.V + (rw_ + 32 + vr) * J.ldv + vc); } while (0)
#define SWRITE(b, i) do { *reinterpret_cast<bf16x8*>(K1s + (b) * KB1 + k1off) = sr_[i].k1; \
        if (DK2 > 0 && tid < 256) *reinterpret_cast<bf16x8*>(K2s + (b) * KB2 + k2off) = sr_[i].k2; \
        *reinterpret_cast<bf16x8*>(Vs + (b) * VBY + vst0) = sr_[i].v0; \
        if (DV == 128) *reinterpret_cast<bf16x8*>(Vs + (b) * VBY + vst1) = sr_[i].v1; } while (0)
#define RESC(a) do { if (__any((a) < 1.f)) { if (hi == 0) al_l[r32] = (a); asm volatile("s_waitcnt lgkmcnt(0)" ::: "memory"); \
        _Pragma("unroll") for (int d = 0; d < NC; ++d) _Pragma("unroll") for (int r = 0; r < 16; ++r) o[d][r] *= al_l[crow(r, hi)]; } } while (0)
#define MASK(P0, P1, t) do { if (J.win && (t) < J.nt1) wmask(P0, P1, J.kpos0 + 64 * (t), qp, hi); } while (0)
    f32x16 pA0, pA1, pB0, pB1; float mnA, mnB, alA, alB; bf16x8 pa0, pa1, pa2, pa3;
    SLOAD(0, 0); SWRITE(0, 0); LBAR();
    qkt<DK2>(pA0, pA1, K1s, K2s, qr, r32, hi); MASK(pA0, pA1, 0); partialSM(pA0, pA1, m_reg, mnA, alA);
    SLOAD(1, 1); if (2 < NT) SLOAD(0, 2);
    SWRITE(1, 1); LBAR();
    for (int j = 1; j + 1 < NT; j += 2) {
        SBAR(); qkt<DK2>(pB0, pB1, K1s + KB1, K2s + KB2, qr, r32, hi); MASK(pB0, pB1, j);
        finishSM(pA0, pA1, alA, l_reg, pa0, pa1, pa2, pa3); SBAR();
        SLOAD(1, j + 2); SBAR();
        pv_all<NC>(o, vb0, pa0, pa1, pa2, pa3); partialSM(pB0, pB1, m_reg, mnB, alB);
        LBAR(); SWRITE(0, 0);
        RESC(alB); LBAR();
        SBAR(); qkt<DK2>(pA0, pA1, K1s, K2s, qr, r32, hi); MASK(pA0, pA1, j + 1);
        finishSM(pB0, pB1, alB, l_reg, pa0, pa1, pa2, pa3); SBAR();
        if (j + 3 < NT) SLOAD(0, j + 3); SBAR();
        pv_all<NC>(o, vb0 + VBY, pa0, pa1, pa2, pa3); partialSM(pA0, pA1, m_reg, mnA, alA);
        LBAR(); SWRITE(1, 1);
        RESC(alA); LBAR();
    }
    SBAR(); qkt<DK2>(pB0, pB1, K1s + KB1, K2s + KB2, qr, r32, hi); MASK(pB0, pB1, NT - 1);
    finishSM(pA0, pA1, alA, l_reg, pa0, pa1, pa2, pa3); SBAR();
    pv_all<NC>(o, vb0, pa0, pa1, pa2, pa3); partialSM(pB0, pB1, m_reg, mnB, alB);
    LBAR(); RESC(alB);
    finishSM(pB0, pB1, alB, l_reg, pa0, pa1, pa2, pa3); SBAR();
    pv_all<NC>(o, vb0 + VBY, pa0, pa1, pa2, pa3);
    if (hi == 0) li_l[r32] = l_reg; asm volatile("s_waitcnt lgkmcnt(0)" ::: "memory");
    int tide = tid; asm volatile("" : "+v"(tide));
    const int r32e = tide & 31, hie = (tide >> 5) & 1, wide = tide >> 6;
    float rli[16];
#pragma unroll
    for (int r = 0; r < 16; ++r) rli[r] = 1.0f / li_l[crow(r, hie)];
    if (J.omode == 0) {
        bf16_t* Ow = J.Ob + (unsigned)((wide * 32 + 4 * hie) * J.ldo + r32e);
#pragma unroll
        for (int r = 0; r < 16; ++r) { const unsigned ro = (unsigned)(((r & 3) + 8 * (r >> 2)) * J.ldo);
#pragma unroll
            for (int d0 = 0; d0 < NC; ++d0) Ow[ro + d0 * 32] = (bf16_t)(cvtpk(o[d0][r] * rli[r], 0.f) & 0xffffu); }
    } else if (J.omode == 1) {
        float* Ow = J.Of + (unsigned)((wide * 32 + 4 * hie) * J.ldf + r32e);
#pragma unroll
        for (int r = 0; r < 16; ++r) { const unsigned ro = (unsigned)(((r & 3) + 8 * (r >> 2)) * J.ldf);
#pragma unroll
            for (int d0 = 0; d0 < NC; ++d0) Ow[ro + d0 * 32] = o[d0][r] * rli[r]; }
    } else {
        const float* Fw = J.Of + (unsigned)((wide * 32 + 4 * hie) * J.ldf + r32e); bf16_t* Ow = J.Ob + (unsigned)((wide * 32 + 4 * hie) * J.ldo + r32e);
        float gv[NC];
#pragma unroll
        for (int d0 = 0; d0 < NC; ++d0) gv[d0] = J.subg[d0 * 32 + r32e] * 0.8f;
#pragma unroll
        for (int r = 0; r < 16; ++r) { const unsigned rf = (unsigned)(((r & 3) + 8 * (r >> 2)) * J.ldf), ro = (unsigned)(((r & 3) + 8 * (r >> 2)) * J.ldo); float val[NC]; float ss = 0.f;
#pragma unroll
            for (int d0 = 0; d0 < NC; ++d0) { val[d0] = Fw[rf + d0 * 32] - J.lam * (o[d0][r] * rli[r]); ss += val[d0] * val[d0]; }
            ss += __shfl_xor(ss, 1); ss += __shfl_xor(ss, 2); ss += __shfl_xor(ss, 4); ss += __shfl_xor(ss, 8); ss += __shfl_xor(ss, 16);
            const float rstd = 1.0f / sqrtf(ss * (1.0f / (32 * NC)) + EPS);
#pragma unroll
            for (int d0 = 0; d0 < NC; ++d0) Ow[ro + d0 * 32] = (bf16_t)(cvtpk(val[d0] * rstd * gv[d0], 0.f) & 0xffffu);
            asm volatile("" ::: "memory"); }
    }
#undef TROW
#undef SLOAD
#undef SWRITE
#undef RESC
#undef MASK
}
#undef SBAR
#undef LBAR
}

DI float wave_sum(float v) {
#pragma unroll
    for (int o = 1; o < 64; o <<= 1) v += __shfl_xor(v, o);
    return v;
}
DI unsigned pk2(float lo, float hi) { return pg8::cvt_pk_bf16(lo, hi); }

struct RowOp {
    const float* rin_lat; const float* rin_ctx;
    const float* Y; const float* gY; const float* gate;
    float* rout_lat; float* rout_ctx;
    const float* gN; const float* shift; const float* scale; bf16_t* H;
    int nrows;
};
DI void rowop_phase(const RowOp& P, int gw, int ngw, int lane) {
    for (int row = gw; row < P.nrows; row += ngw) {
        const int g = row < SEQ ? 0 : (row < RL ? 1 : 2);
        const float* xin = row < RL ? P.rin_lat + (size_t)row * DM : P.rin_ctx + (size_t)(row - RL) * DM;
        f32x4 x[4];
#pragma unroll
        for (int j = 0; j < 4; ++j) x[j] = *(const f32x4*)(xin + 4 * lane + 256 * j);
        if (P.Y) {
            f32x4 y[4]; float ss = 0.f;
#pragma unroll
            for (int j = 0; j < 4; ++j) { y[j] = *(const f32x4*)(P.Y + (size_t)row * DM + 4 * lane + 256 * j); ss += (y[j][0] * y[j][0] + y[j][1] * y[j][1]) + (y[j][2] * y[j][2] + y[j][3] * y[j][3]); }
            const float rstd = 1.0f / sqrtf(wave_sum(ss) * (1.0f / DM) + EPS);
#pragma unroll
            for (int j = 0; j < 4; ++j) { const f32x4 gy = *(const f32x4*)(P.gY + 4 * lane + 256 * j), gt = *(const f32x4*)(P.gate + g * 6144 + 4 * lane + 256 * j);
                x[j] = x[j] + gt * ((y[j] * rstd) * gy); }
        }
        float* xo = row < RL ? (P.rout_lat ? P.rout_lat + (size_t)row * DM : nullptr) : (P.rout_ctx ? P.rout_ctx + (size_t)(row - RL) * DM : nullptr);
        if (xo) {
#pragma unroll
            for (int j = 0; j < 4; ++j) *(f32x4*)(xo + 4 * lane + 256 * j) = x[j];
        }
        if (P.H) {
            float ss = 0.f;
#pragma unroll
            for (int j = 0; j < 4; ++j) ss += (x[j][0] * x[j][0] + x[j][1] * x[j][1]) + (x[j][2] * x[j][2] + x[j][3] * x[j][3]);
            const float rstd = 1.0f / sqrtf(wave_sum(ss) * (1.0f / DM) + EPS);
#pragma unroll
            for (int j = 0; j < 4; ++j) { const int c = 4 * lane + 256 * j;
                const f32x4 gn = *(const f32x4*)(P.gN + c), sh = *(const f32x4*)(P.shift + g * 6144 + c), sc = *(const f32x4*)(P.scale + g * 6144 + c);
                const f32x4 h = ((x[j] * rstd) * gn) * (sc + 1.0f) + sh;
                u32x2 w; w.x = pk2(h[0], h[1]); w.y = pk2(h[2], h[3]);
                *(u32x2*)(P.H + (size_t)row * DM + c) = w; }
        }
    }
}
DI void mla_prep_phase(const float* P1, const float* qg, const float* kvg, const float* tabc, bf16_t* QL, bf16_t* KVL, bf16_t* KR, int gw, int ngw, int lane) {
    for (int row = gw; row < RT; row += ngw) {
        const float* p = P1 + (size_t)row * 768 + 4 * lane;
        const f32x4 v0 = *(const f32x4*)p, v1 = *(const f32x4*)(p + 256), v2 = *(const f32x4*)(p + 512);
        const float s0 = (v0[0] * v0[0] + v0[1] * v0[1]) + (v0[2] * v0[2] + v0[3] * v0[3]);
        const float s1 = (v1[0] * v1[0] + v1[1] * v1[1]) + (v1[2] * v1[2] + v1[3] * v1[3]);
        const float s2 = (v2[0] * v2[0] + v2[1] * v2[1]) + (v2[2] * v2[2] + v2[3] * v2[3]);
        const float ssq = wave_sum(s0 + (lane < 32 ? s1 : 0.f));
        const float sskv = wave_sum((lane >= 32 ? s1 : 0.f) + (lane < 32 ? s2 : 0.f));
        const float rq = 1.0f / sqrtf(ssq * (1.0f / 384) + EPS), rkv = 1.0f / sqrtf(sskv * (1.0f / 256) + EPS);
        { const f32x4 g = *(const f32x4*)(qg + 4 * lane); const f32x4 h = (v0 * rq) * g; u32x2 w; w.x = pk2(h[0], h[1]); w.y = pk2(h[2], h[3]); *(u32x2*)(QL + (size_t)row * 384 + 4 * lane) = w; }
        if (lane < 32) { const f32x4 g = *(const f32x4*)(qg + 256 + 4 * lane); const f32x4 h = (v1 * rq) * g; u32x2 w; w.x = pk2(h[0], h[1]); w.y = pk2(h[2], h[3]); *(u32x2*)(QL + (size_t)row * 384 + 256 + 4 * lane) = w; }
        else { const f32x4 g = *(const f32x4*)(kvg + 4 * (lane - 32)); const f32x4 h = (v1 * rkv) * g; u32x2 w; w.x = pk2(h[0], h[1]); w.y = pk2(h[2], h[3]); *(u32x2*)(KVL + (size_t)row * 256 + 4 * (lane - 32)) = w; }
        if (lane < 32) { const f32x4 g = *(const f32x4*)(kvg + 128 + 4 * lane); const f32x4 h = (v2 * rkv) * g; u32x2 w; w.x = pk2(h[0], h[1]); w.y = pk2(h[2], h[3]); *(u32x2*)(KVL + (size_t)row * 256 + 128 + 4 * lane) = w; }
        f32x4 pr; pr[0] = __shfl_xor(v2[0], 2); pr[1] = __shfl_xor(v2[1], 2); pr[2] = __shfl_xor(v2[2], 2); pr[3] = __shfl_xor(v2[3], 2);
        if (lane >= 32 && lane < 40) {
            const int q = lane - 32; f32x4 h = v2;
            if (row < RL) {
                const int t = row & (SEQ - 1), pos = (q < 4) ? (t >> 6) : (t & 63);
                const float* tp = tabc + (size_t)(pos * 8 + 4 * (q & 1)) * 2;
                const f32x4 cs01 = *(const f32x4*)tp, cs23 = *(const f32x4*)(tp + 4);
                const f32x4 cs = {cs01[0], cs01[2], cs23[0], cs23[2]}, sn = {cs01[1], cs01[3], cs23[1], cs23[3]};
                const f32x4 sg = (q & 2) ? sn : -sn;
                h = v2 * cs + pr * sg;
            }
            u32x2 w; w.x = pk2(h[0], h[1]); w.y = pk2(h[2], h[3]); *(u32x2*)(KR + (size_t)row * 32 + 4 * q + ((q >> 1) == 1 ? 8 : ((q >> 1) == 2 ? -8 : 0))) = w;
        }
    }
}

DI void transpose_item(const float* W, int N, int k0, int n0, bf16_t* WT, int ldt, int orow0, LAS float* scr, int lane, bool perm = false) {
#pragma unroll 8
    for (int i = 0; i < 32; ++i) { const int kk = 2 * i + (lane >> 5); scr[kk * 33 + (lane & 31)] = W[(size_t)(k0 + kk) * N + n0 + (lane & 31)]; }
    asm volatile("s_waitcnt lgkmcnt(0)" ::: "memory");
    const int c = lane & 7;
#pragma unroll
    for (int j = 0; j < 4; ++j) { const int n = (lane >> 3) + 8 * j; const LAS float* s = scr + (8 * c) * 33 + n;
        u32x4 o; o.x = pk2(s[0 * 33], s[1 * 33]); o.y = pk2(s[2 * 33], s[3 * 33]); o.z = pk2(s[4 * 33], s[5 * 33]); o.w = pk2(s[6 * 33], s[7 * 33]);
        const int np = perm ? (((n >> 3) == 1) ? n + 8 : (((n >> 3) == 2) ? n - 8 : n)) : n;
        *(u32x4*)(WT + (size_t)(orow0 + np) * ldt + k0 + 8 * c) = o; }
    asm volatile("s_waitcnt lgkmcnt(0)" ::: "memory");
}
DI void sincos_acc(float ang, float& c, float& s) {
    const double a = (double)ang, twopi = 6.283185307179586476925287;
    const double k = __builtin_rint(a / twopi); const double r = a - k * twopi;
    const double r2 = r * r; double ts = r, tc = 1.0, ss = r, cc = 1.0;
#pragma unroll
    for (int i = 1; i <= 13; ++i) { tc = -tc * r2 / (double)((2 * i - 1) * (2 * i)); cc += tc; ts = -ts * r2 / (double)((2 * i) * (2 * i + 1)); ss += ts; }
    c = (float)cc; s = (float)ss;
}
__device__ const float INVF_AB[16] = {1.000000000e+00f, 5.623413324e-01f, 3.162277639e-01f, 1.778279394e-01f, 1.000000015e-01f, 5.623413250e-02f, 3.162277490e-02f, 1.778279431e-02f,
                                      9.999999776e-03f, 5.623413250e-03f, 3.162277630e-03f, 1.778279431e-03f, 1.000000047e-03f, 5.623413017e-04f, 3.162277571e-04f, 1.778279402e-04f};
__device__ const float INVF_C[8] = {1.000000000e+00f, 3.162277639e-01f, 1.000000015e-01f, 3.162277490e-02f, 9.999999776e-03f, 3.162277630e-03f, 1.000000047e-03f, 3.162277571e-04f};

struct Args { const float* in[20]; float* out; unsigned char* ws; int ph_lo, ph_hi; };

DI void prologue_phase(const Args& A, LAS unsigned char* lds) {
    int tid_ = threadIdx.x; asm volatile("" : "+v"(tid_));
    int bx_ = blockIdx.x; asm volatile("" : "+s"(bx_));
    const int tid = tid_, lane = tid & 63, wave = tid >> 6, G = gridDim.x, bx = bx_;
    unsigned char* ws = A.ws;
    {
        LAS float* sv = (LAS float*)lds;
        LAS float* red = (LAS float*)(lds + 16384);
        bool did = false;
        for (int item = bx; item < 192; item += G) {
            if (!did) {
                for (int i = tid; i < 3072; i += NTHR) { const float v = i < 2048 ? A.in[1][i] : A.in[3][i - 2048]; sv[i] = v / (1.0f + __expf(-v)); }
                __syncthreads(); did = true;
            }
            const int l = item / 96, n0 = (item % 96) * 64, c = lane, ks = wave;
            const float* W = A.in[4] + (size_t)l * 1024 * 6144 + n0 + c;
            float a0 = 0.f, a1 = 0.f, a2 = 0.f;
#pragma unroll 8
            for (int k = ks * 128; k < ks * 128 + 128; ++k) { const float w = W[(size_t)k * 6144]; a0 += sv[k] * w; a1 += sv[1024 + k] * w; a2 += sv[2048 + k] * w; }
            red[(ks * 3 + 0) * 64 + c] = a0; red[(ks * 3 + 1) * 64 + c] = a1; red[(ks * 3 + 2) * 64 + c] = a2;
            __syncthreads();
            if (tid < 192) { const int g = tid >> 6, cc = tid & 63; float s = A.in[5][l * 6144 + n0 + cc];
#pragma unroll
                for (int k8 = 0; k8 < 8; ++k8) s += red[(k8 * 3 + g) * 64 + cc];
                ((float*)(ws + OFF_MOD))[(size_t)(l * 3 + g) * 6144 + n0 + cc] = s; }
            __syncthreads();
        }
        __syncthreads();
    }
    if (bx == G - 1) {
        float* tab = (float*)(ws + OFF_TAB_AB); float* tabc = (float*)(ws + OFF_TAB_C);
        for (int e = tid; e < 2048; e += NTHR) { const int pos = e >> 4, i = e & 15; float c, s; sincos_acc((float)pos * INVF_AB[i], c, s); tab[2 * e] = c; tab[2 * e + 1] = s; }
        for (int e = tid; e < 1024; e += NTHR) { const int pos = e >> 3, i = e & 7; float c, s; sincos_acc((float)pos * INVF_C[i], c, s); tabc[2 * e] = c; tabc[2 * e + 1] = s; }
    }
    { u32x4* z = (u32x4*)(ws + W_MIN + (size_t)672 * 1024 * 2); const u32x4 zero = {0u, 0u, 0u, 0u};
      for (int i = bx * NTHR + tid; i < 96 * 1024 * 2 / 16; i += G * NTHR) z[i] = zero; }
    {
        LAS float* scr = (LAS float*)(lds + wave * 16384);
        const int gw = bx * NWAVES + wave, ngw = G * NWAVES;
        constexpr int I1 = 16 * 72, I2 = 16 * 32, I3 = 16 * 176, I4 = 44 * 32, I5 = 16 * 21, I6 = 6 * 48, I7 = 4 * 64, I8 = 16 * 32;
        constexpr int NITEMS = I1 + I2 + 2 * I3 + 2 * I4 + I5 + I6 + I7 + I8;
        for (int it = gw; it < NITEMS; it += ngw) {
            int r = it;
            if (r < I1) { const int kb = r / 72, nb = r % 72; transpose_item(A.in[9], 2304, 64 * kb, 32 * nb, (bf16_t*)(ws + W_ABIN), 1024, 32 * nb, scr, lane); continue; } r -= I1;
            if (r < I2) { const int kb = r / 32, nb = r % 32; transpose_item(A.in[10], 1024, 64 * kb, 32 * nb, (bf16_t*)(ws + W_ABOUT), 1024, 32 * nb, scr, lane); continue; } r -= I2;
            if (r < 2 * I3) { const int l = r / I3, q = r % I3, kb = q / 176, nb = q % 176, n0 = 32 * nb, half = n0 / FH, rem = n0 % FH;
                transpose_item(A.in[7] + (size_t)l * 1024 * 5632, 5632, 64 * kb, n0, (bf16_t*)(ws + W_13) + (size_t)l * 5632 * 1024, 1024, 256 * (rem / 128) + 128 * half + (rem % 128), scr, lane); continue; } r -= 2 * I3;
            if (r < 2 * I4) { const int l = r / I4, q = r % I4, kb = q / 32, nb = q % 32;
                transpose_item(A.in[8] + (size_t)l * FH * 1024, 1024, 64 * kb, 32 * nb, (bf16_t*)(ws + W_2) + (size_t)l * 1024 * FH, FH, 32 * nb, scr, lane); continue; } r -= 2 * I4;
            if (r < I5) { const int kb = r / 21, nb = r % 21; transpose_item(A.in[14], 672, 64 * kb, 32 * nb, (bf16_t*)(ws + W_MIN), 1024, 32 * nb, scr, lane); continue; } r -= I5;
            if (r < I6) { const int kb = r / 48, nb = r % 48; transpose_item(A.in[17], 1536, 64 * kb, 32 * nb, (bf16_t*)(ws + W_QB), 384, 32 * nb, scr, lane, (nb % 3) == 2); continue; } r -= I6;
            if (r < I7) { const int kb = r / 64, nb = r % 64; transpose_item(A.in[18], 2048, 64 * kb, 32 * nb, (bf16_t*)(ws + W_KVB), 256, 32 * nb, scr, lane); continue; } r -= I7;
            { const int kb = r / 32, nb = r % 32; transpose_item(A.in[19], 1024, 64 * kb, 32 * nb, (bf16_t*)(ws + W_MOUT), 1024, 32 * nb, scr, lane); }
        }
    }
}

DI void attn_layer0_phase(const Args& A, char* lds) {
    int tid_ = threadIdx.x; asm volatile("" : "+v"(tid_));
    int bx_ = blockIdx.x; asm volatile("" : "+s"(bx_));
    unsigned char* ws = A.ws; const int G = gridDim.x, bx = bx_, lane = tid_ & 63;
    const bf16_t* PQ = (const bf16_t*)(ws + OFF_BIG); bf16_t* OA = (bf16_t*)(ws + OFF_HXR); float* OD = (float*)(ws + OFF_YR);
    const float* lv = A.in[12];
    const float lam = __expf(wave_sum(lv[lane] * lv[64 + lane])) - __expf(wave_sum(lv[128 + lane] * lv[192 + lane])) + 0.2f;
    const float* subg = A.in[13];
#ifndef NO_B
    for (int pu = bx; pu < 256 + 8; pu += G) {
        int b, hb, qrow0, ctxq;
        if (pu < 256) { const int x = pu & 7; b = x >> 2; hb = x & 3; qrow0 = b * SEQ + (pu >> 3) * 256; ctxq = 0; }
        else { const int x = pu - 256; b = x >> 2; hb = x & 3; qrow0 = RL + b * CTXL; ctxq = 1; }
#pragma unroll 1
        for (int mh = 0; mh < 2; ++mh) {
            att::Job J;
            J.Q = PQ + (size_t)qrow0 * ABW + 512 + hb * 128 + mh * 64; J.ldq = ABW;
            J.K1 = PQ + 1280 + hb * 128 + mh * 64; J.ldk1 = ABW; J.K2 = PQ; J.ldk2 = ABW;
            J.V = PQ + 1792 + hb * 128; J.ldv = ABW;
            if (ctxq) { J.row1 = RL + b * CTXL; J.nt1 = 4; J.row2 = 0; J.nt2 = 0; }
            else { J.row1 = b * SEQ; J.nt1 = SEQ / 64; J.row2 = RL + b * CTXL; J.nt2 = 4; }
            J.win = 0; J.qpos0 = 0; J.kpos0 = 0; J.m0 = att::NEGBIG; J.l0 = 0.f;
            J.omode = mh ? 2 : 1;
            J.Ob = OA + (size_t)qrow0 * DM + 512 + hb * 128; J.ldo = DM;
            J.Of = OD + (size_t)qrow0 * 512 + hb * 128; J.ldf = 512;
            J.lam = lam; J.subg = subg;
            att::unit<0, 128>(J, lds);
        }
    }
#endif
#ifndef NO_A
    for (int u = bx; u < 512 + 16; u += G) {
        att::Job J; int b, h, qrow0;
        if (u < 512) {
            const int qb = u & 31; h = (u >> 5) & 7; b = u >> 8; qrow0 = b * SEQ + qb * 256;
            const int k0 = qb * 256 - 128 < 0 ? 0 : qb * 256 - 128, k1 = qb * 256 + 384 > SEQ ? SEQ : qb * 256 + 384;
            J.row1 = b * SEQ + k0; J.nt1 = (k1 - k0) / 64; J.row2 = RL + b * CTXL; J.nt2 = 4; J.win = 1; J.qpos0 = qb * 256; J.kpos0 = k0;
        } else {
            const int x = u - 512; b = x >> 3; h = x & 7; qrow0 = RL + b * CTXL;
            J.row1 = RL + b * CTXL; J.nt1 = 4; J.row2 = 0; J.nt2 = 0; J.win = 0; J.qpos0 = 0; J.kpos0 = 0;
        }
        J.Q = PQ + (size_t)qrow0 * ABW + h * 64; J.ldq = ABW;
        J.K1 = PQ + 1024 + (h >> 2) * 64; J.ldk1 = ABW; J.K2 = PQ; J.ldk2 = ABW;
        J.V = PQ + 1152 + (h >> 2) * 64; J.ldv = ABW;
        J.m0 = A.in[11][h] * LOG2E; J.l0 = 1.f; J.omode = 0;
        J.Ob = OA + (size_t)qrow0 * DM + h * 64; J.ldo = DM; J.Of = OD; J.ldf = 512; J.lam = 0.f; J.subg = subg;
        att::unit<0, 64>(J, lds);
    }
#endif
}
DI void attn_mla_phase(const Args& A, char* lds) {
    int bx_ = blockIdx.x; asm volatile("" : "+s"(bx_));
    unsigned char* ws = A.ws; const int G = gridDim.x, bx = bx_;
    const bf16_t* Q1 = (const bf16_t*)(ws + OFF_YR); const bf16_t* KV = (const bf16_t*)(ws + OFF_BIG); const bf16_t* KR = (const bf16_t*)(ws + OFF_KR);
    bf16_t* OA = (bf16_t*)(ws + OFF_HXR);
    for (int u = bx; u < 1024; u += G) {
        const int i = u >> 8, cc = u & 255, bh = i * 8 + (cc & 7), qb = cc >> 3, b = bh >> 4, h = bh & 15, qrow0 = b * SEQ + qb * 256;
        att::Job J;
        J.Q = Q1 + (size_t)qrow0 * 1536 + h * 96; J.ldq = 1536;
        J.K1 = KV + h * 128; J.ldk1 = 2048; J.K2 = KR; J.ldk2 = 32; J.V = KV + h * 128 + 64; J.ldv = 2048;
        J.row1 = b * SEQ; J.nt1 = SEQ / 64; J.row2 = RL + b * CTXL; J.nt2 = 4; J.win = 0; J.qpos0 = 0; J.kpos0 = 0;
        J.m0 = att::NEGBIG; J.l0 = 0.f; J.omode = 0;
        J.Ob = OA + (size_t)qrow0 * DM + h * 64; J.ldo = DM; J.Of = nullptr; J.ldf = 0; J.lam = 0.f; J.subg = nullptr;
        att::unit<32, 64>(J, lds);
    }
}

DI int fresh_bx() { int b = blockIdx.x; asm volatile("" : "+s"(b)); return b; }
constexpr int N_PHASES = 18;
typedef const __attribute__((address_space(4))) Args* KArgsP;
DI Args load_args() {
#if defined(__HIP_DEVICE_COMPILE__)
    KArgsP p = (KArgsP)__builtin_amdgcn_kernarg_segment_ptr(); asm volatile("" : "+s"(p)); return *p;
#else
    return Args{};
#endif
}
DI bool phase_in(int k) {
#if defined(__HIP_DEVICE_COMPILE__)
    KArgsP p = (KArgsP)__builtin_amdgcn_kernarg_segment_ptr(); asm volatile("" : "+s"(p)); return p->ph_lo <= k && k < p->ph_hi;
#else
    return false;
#endif
}
__global__ void __launch_bounds__(NTHR, 2) dit_fwd(Args A_) {
    extern __shared__ __attribute__((aligned(16))) unsigned char lds_raw[];
    LAS unsigned char* lds = (LAS unsigned char*)lds_raw;
#ifndef DISMASK
#define DISMASK 0
#endif
#define EN(n) (!((DISMASK >> (n)) & 1))
#ifndef REPMASK
#define REPMASK 0
#endif
#define REP(n) _Pragma("unroll 1") for (int rep_ = 0; rep_ < ((((REPMASK) >> (n)) & 1) ? 2 : 1); ++rep_)
#define IN(k) phase_in(k)
    if (threadIdx.x < 2) ((volatile LAS unsigned*)(lds + LDS_ST_OFF))[threadIdx.x] = 0u;
    __syncthreads();
    if (phase_in(0) && phase_in(1)) { const Args Ab = load_args(); (void)xcd_barrier_post((unsigned*)(Ab.ws + OFF_BAR), (volatile LAS unsigned*)(lds + LDS_ST_OFF)); }
    if (phase_in(-7)) cg::this_grid().sync();
#define SEAM(k) do { if (IN(k) && IN((k) + 1)) { const Args Ab = load_args(); XcdBarrier bar_; bar_.bar = (unsigned*)(Ab.ws + OFF_BAR); bar_.x = xb_xcc_id(); bar_.st = (volatile LAS unsigned*)(lds + LDS_ST_OFF); xcd_barrier(bar_); } } while (0)
#define FRESH() const Args A = load_args(); unsigned char* ws = A.ws; (void)ws; int tid_ = threadIdx.x; asm volatile("" : "+v"(tid_)); \
    const int lane = tid_ & 63, ngw = (int)gridDim.x * NWAVES, gw = fresh_bx() * NWAVES + __builtin_amdgcn_readfirstlane(tid_ >> 6); (void)lane; (void)gw; (void)ngw; \
    float* mod = (float*)(ws + OFF_MOD); bf16_t* HX = (bf16_t*)(ws + OFF_HXR); float* Y = (float*)(ws + OFF_YR); float* XSC = (float*)(ws + OFF_XSC); const float* normg = A.in[6]; \
    (void)mod; (void)HX; (void)Y; (void)XSC; (void)normg

    if (IN(0) && EN(0)) REP(0) { FRESH(); prologue_phase(A, lds); } SEAM(0);
    if (IN(1) && EN(1)) REP(1) {
        FRESH(); RowOp P{A.in[0], A.in[2], nullptr, nullptr, nullptr, nullptr, nullptr, normg, mod + 0 * 1024, mod + 1 * 1024, HX, RT};
        rowop_phase(P, gw, ngw, lane);
    } SEAM(1);
#pragma unroll 1
    for (int l = 0; l < 2; ++l) {
        const int pb = l == 0 ? 4 : 13;
        if (l == 0) {
            if (IN(2) && EN(2)) REP(2) { FRESH(); EpiQKV E{(bf16_t*)(ws + OFF_BIG), (const float*)(ws + OFF_TAB_AB)}; run_gemm(lds, HX, DM, (const bf16_t*)(ws + W_ABIN), RT, ABW, DM, E); } SEAM(2);
            if (IN(3) && EN(3)) REP(3) { FRESH(); attn_layer0_phase(A, (char*)lds_raw); } SEAM(3);
        } else {
            if (IN(9) && EN(9)) REP(9) { FRESH(); EpiF32 E{(float*)(ws + OFF_BIG), 768}; run_gemm(lds, HX, DM, (const bf16_t*)(ws + W_MIN), RT, 768, DM, E); } SEAM(9);
            if (IN(10) && EN(10)) REP(10) { FRESH(); mla_prep_phase((const float*)(ws + OFF_BIG), A.in[15], A.in[16], (const float*)(ws + OFF_TAB_C), (bf16_t*)(ws + OFF_QL), (bf16_t*)(ws + OFF_KVL), (bf16_t*)(ws + OFF_KR), gw, ngw, lane); } SEAM(10);
            if (IN(11) && EN(11)) REP(11) {
                { FRESH(); EpiMlaQ E{(bf16_t*)(ws + OFF_YR), (const float*)(ws + OFF_TAB_C)}; run_gemm(lds, (const bf16_t*)(ws + OFF_QL), 384, (const bf16_t*)(ws + W_QB), RL, 1536, 384, E); }
                { FRESH(); EpiBf16P E{(bf16_t*)(ws + OFF_BIG), 2048}; run_gemm(lds, (const bf16_t*)(ws + OFF_KVL), 256, (const bf16_t*)(ws + W_KVB), RT, 2048, 256, E); }
            } SEAM(11);
            if (IN(12) && EN(12)) REP(12) { FRESH(); attn_mla_phase(A, (char*)lds_raw); } SEAM(12);
        }
        const int M_l = l == 0 ? RT : RL;
        if (IN(pb) && EN(4)) REP(4) { FRESH(); EpiF32 E{Y, DM}; run_gemm(lds, HX  , DM, (const bf16_t*)(ws + (l == 0 ? W_ABOUT : W_MOUT)), M_l, DM, DM, E); } SEAM(pb);
        if (IN(pb + 1) && EN(5)) REP(5) {
            FRESH(); const float* modl = mod + (size_t)l * 3 * 6144;
            RowOp P{l == 0 ? A.in[0] : A.out, l == 0 ? A.in[2] : XSC, Y, normg + (l * 4 + 1) * DM, modl + 2 * 1024, A.out, XSC,
                    normg + (l * 4 + 2) * DM, modl + 3 * 1024, modl + 4 * 1024, HX, M_l};
            rowop_phase(P, gw, ngw, lane);
        } SEAM(pb + 1);
        if (IN(pb + 2) && EN(6)) REP(6) { FRESH(); EpiSwiGLU E{(bf16_t*)(ws + OFF_BIG), FH}; run_gemm(lds, HX, DM, (const bf16_t*)(ws + W_13) + (size_t)l * 5632 * 1024, M_l, 5632, DM, E); } SEAM(pb + 2);
        if (IN(pb + 3) && EN(7)) REP(7) { FRESH(); EpiF32 E{Y, DM}; run_gemm(lds, (const bf16_t*)(ws + OFF_BIG), FH, (const bf16_t*)(ws + W_2) + (size_t)l * 1024 * FH, M_l, DM, FH, E); } SEAM(pb + 3);
        if (IN(pb + 4) && EN(8)) REP(8) {
            FRESH(); const float* modl = mod + (size_t)l * 3 * 6144; const float* mod1 = mod + (size_t)3 * 6144;
            RowOp P{A.out, XSC, Y, normg + (l * 4 + 3) * DM, modl + 5 * 1024, A.out, l == 0 ? XSC : nullptr,
                    normg + 4 * DM, mod1 + 0 * 1024, mod1 + 1 * 1024, l == 0 ? HX : nullptr, M_l};
            rowop_phase(P, gw, ngw, lane);
        }
        if (l == 0) SEAM(8);
    }
#undef IN
#undef SEAM
#undef FRESH
}

extern "C" void kernel_launch(void* const* d_in, const int* in_sizes, int n_in, void* d_out, int out_size, void* d_ws, size_t ws_size, hipStream_t stream) {
    static int grid = 0;
    if (grid == 0) {
        if (n_in != 20 || in_sizes[0] != RL * DM || out_size != RL * DM || ws_size < WS_END) { fprintf(stderr, "kernel_launch: unexpected shapes (n_in %d, in0 %d, out %d, ws %zu)\n", n_in, n_in > 0 ? in_sizes[0] : -1, out_size, ws_size); grid = -1; return; }
        int dev = 0, cus = 0, per_cu = 0;
        if (hipGetDevice(&dev) != hipSuccess || hipDeviceGetAttribute(&cus, hipDeviceAttributeMultiprocessorCount, dev) != hipSuccess) { grid = -1; return; }
        if (hipFuncSetAttribute((const void*)dit_fwd, hipFuncAttributeMaxDynamicSharedMemorySize, LDS_BYTES) != hipSuccess) { fprintf(stderr, "kernel_launch: hipFuncSetAttribute failed\n"); grid = -1; return; }
        if (hipOccupancyMaxActiveBlocksPerMultiprocessor(&per_cu, (const void*)dit_fwd, NTHR, LDS_BYTES) != hipSuccess || per_cu < 1) { fprintf(stderr, "kernel_launch: occupancy query says %d\n", per_cu); per_cu = 1; }
        (void)hipGetLastError();
        grid = cus * per_cu;
    }
    if (grid < 0) return;
    Args a{};
    for (int i = 0; i < 20; ++i) a.in[i] = (const float*)d_in[i];
    a.out = (float*)d_out; a.ws = (unsigned char*)d_ws;
#if MK_PER_PHASE
    for (int p = 0; p < N_PHASES; ++p) { a.ph_lo = p; a.ph_hi = p + 1; hipLaunchKernelGGL(dit_fwd, dim3(grid), dim3(NTHR), LDS_BYTES, stream, a); }
#else
    a.ph_lo = 0; a.ph_hi = N_PHASES;
    if (hipMemsetAsync((char*)d_ws + OFF_BAR, 0, XCD_BAR_WORDS * sizeof(unsigned), stream) != hipSuccess) { fprintf(stderr, "kernel_launch: memset of the barrier words failed\n"); return; }
    void* args[] = {&a};
    hipError_t e = hipLaunchCooperativeKernel((const void*)dit_fwd, dim3(grid), dim3(NTHR), args, LDS_BYTES, stream);
    if (e != hipSuccess) fprintf(stderr, "cooperative launch failed: %s (grid %d)\n", hipGetErrorString(e), grid);
#endif
}
```

```cpp
#include <hip/hip_runtime.h>
#include <hip/hip_cooperative_groups.h>
#include <cstdio>
#include <cstdint>
namespace cg = cooperative_groups;
#ifndef MK_PER_PHASE
#define MK_PER_PHASE 0
#endif
namespace pg8 {
#define PG8_LAS __attribute__((address_space(3)))
typedef unsigned short bf16_t;
typedef short bf16x8 __attribute__((ext_vector_type(8)));
typedef float f32x4 __attribute__((ext_vector_type(4)));
typedef unsigned u32x4 __attribute__((ext_vector_type(4)));
constexpr int BM = 256, BK = 64, HALF = 128, HTB = HALF * BK * 2  , STAGE_BYTES = 8 * HTB, NXCD = 8, WGM = 8;

__host__ __device__ __forceinline__ int lds_byte(int r, int c) { const int st = (r >> 4) * 2 + (c >> 5), rr = r & 15, cc = c & 31, ob = rr * 64 + cc * 2; return st * 1024 + (ob ^ (((ob >> 9) & 1) << 5)); }
__host__ __device__ __forceinline__ void stage_rc(int b, int& R, int& C) { const int st = b / 1024, sb = b % 1024, swz = sb ^ (((sb >> 9) & 1) << 5); R = (st >> 1) * 16 + swz / 64; C = (st & 1) * 32 + (swz % 64) / 2; }
__host__ __device__ __forceinline__ int perm32(int rho) { const int n = rho >> 4, i = rho & 15; return 8 * (i >> 2) + 4 * n + (i & 3); }

struct Unit { int pm, pn; };
struct Gemm { const bf16_t* A; const bf16_t* Bt; int M, N, K, lda, ldb, csplit; };

struct StaticOrder {
    int nM, nN, nwg, G, c;
    __host__ __device__ void init(int M, int N, int G_, int c_) { nM = M / BM; nN = N / BM; nwg = nM * nN; G = G_; c = c_; }
    __host__ __device__ bool next(int i, Unit& u) const {
        const long L = (long)i * G + c; if (L >= nwg) return false;
        int wgid = (int)L; { const int q = nwg / NXCD, r = nwg % NXCD, xcd = wgid % NXCD, off = wgid / NXCD; wgid = (xcd < r ? xcd * (q + 1) : r * (q + 1) + (xcd - r) * q) + off; }
        const int nig = WGM * nN, gid = wgid / nig, fm = gid * WGM, gsz = (nM - fm) < WGM ? (nM - fm) : WGM;
        u.pm = fm + ((wgid % nig) % gsz); u.pn = (wgid % nig) / gsz; return true;
    }
    __device__ __forceinline__ void a_ready(const Unit&) const {}
    __device__ __forceinline__ void done(const Unit&) const {}
};


__device__ __forceinline__ unsigned cvt_pk_bf16(float lo, float hi) { unsigned r; asm volatile("v_cvt_pk_bf16_f32 %0, %1, %2" : "=v"(r) : "v"(lo), "v"(hi)); return r; }
typedef float f32x2 __attribute__((ext_vector_type(2)));

template <class Epi, class Sched, bool ALIGN_EPI = false, bool SP2 = false>
__device__ __forceinline__ void gemm_phase(PG8_LAS unsigned char* lds, const Gemm g, const Sched& S, const Epi& E) {
    int tid_ = threadIdx.x; asm volatile("" : "+v"(tid_));
    const int tid = tid_, wid = __builtin_amdgcn_readfirstlane(tid >> 6), lane = tid & 63, wr = wid >> 2, wc = wid & 3, fr = lane & 15, fq = lane >> 4;
    const int K = g.K, nt = K / BK;
    unsigned voffA[2], voffB[2];
#pragma unroll
    for (int i = 0; i < 2; ++i) { int R, C; stage_rc(tid * 16 + i * 8192, R, C); const int Rb = Epi::PERM ? ((R & ~31) + perm32(R & 31)) : R;
        voffA[i] = (unsigned)(R * g.lda + C) * 2u; voffB[i] = (unsigned)(Rb * g.ldb + C) * 2u; }
    const size_t kstep = (size_t)(BK * 2);
    const size_t hstep = (size_t)HALF * g.ldb * 2;
    const size_t tstep = 2 * hstep; const size_t hstepA = (size_t)HALF * g.lda * 2, tstepA = 2 * hstepA;
    const unsigned ldsw = (unsigned)wid * 1024u;
    const int aoff = lds_byte(wr * 64 + fr, fq * 8), boff = lds_byte(wc * 32 + fr, fq * 8);
#define PG8_SA(b, h) (((b) * 2 + (h)) * HTB)
#define PG8_SB(b, h) ((4 + (b) * 2 + (h)) * HTB)
#define PG8_STAGE(bufoff, gbase, voff) do { _Pragma("unroll") for (int _i = 0; _i < 2; ++_i) \
        __builtin_amdgcn_global_load_lds((const unsigned*)((const char*)(gbase) + (voff)[_i]), (PG8_LAS unsigned*)(lds + (bufoff) + ldsw + _i * 8192), 16, 0, 0); } while (0)
#define PG8_LDA(dst, b, h) do { _Pragma("unroll") for (int m = 0; m < 4; ++m) _Pragma("unroll") for (int k = 0; k < 2; ++k) dst[m][k] = *(const PG8_LAS bf16x8*)(lds + PG8_SA(b, h) + aoff + m * 2048 + k * 1024); } while (0)
#define PG8_LDB(dst, b, h) do { _Pragma("unroll") for (int n = 0; n < 2; ++n) _Pragma("unroll") for (int k = 0; k < 2; ++k) dst[n][k] = *(const PG8_LAS bf16x8*)(lds + PG8_SB(b, h) + boff + n * 2048 + k * 1024); } while (0)
#define PG8_MMA(ai, bj, At, Bt) do { __builtin_amdgcn_s_setprio(1); _Pragma("unroll") for (int m = 0; m < 4; ++m) _Pragma("unroll") for (int n = 0; n < 2; ++n) _Pragma("unroll") for (int k = 0; k < 2; ++k) \
        acc[ai][bj][m][n] = __builtin_amdgcn_mfma_f32_16x16x32_bf16(Bt[n][k], At[m][k], acc[ai][bj][m][n], 0, 0, 0); __builtin_amdgcn_s_setprio(0); } while (0)
#define PG8_WAIT_V(n) asm volatile("s_waitcnt vmcnt(" #n ")" ::: "memory")
#define PG8_WAIT_L(n) asm volatile("s_waitcnt lgkmcnt(" #n ")" ::: "memory")
#define PG8_BAR __builtin_amdgcn_s_barrier()
#define PG8_SCHED __builtin_amdgcn_sched_barrier(0)
    Unit cur, nxt; int ui = 0;
    if (!S.next(0, cur)) return;
    f32x4 acc[2][2][4][2];
#pragma unroll
    for (int a = 0; a < 2; ++a)
#pragma unroll
        for (int b = 0; b < 2; ++b)
#pragma unroll
            for (int m = 0; m < 4; ++m)
#pragma unroll
                for (int n = 0; n < 2; ++n) acc[a][b][m][n] = (f32x4){0.f, 0.f, 0.f, 0.f};
    bf16x8 At[4][2], B0[2][2], B1[2][2];
    const size_t kcb = (size_t)K * 2;
#define PG8_AOF(u) ((const char*)g.A + (size_t)(u).pm * tstepA + (g.csplit ? (size_t)((u).pn / g.csplit) * kcb : (size_t)0))
#define PG8_BOF(u) ((const char*)g.Bt + (size_t)(g.csplit ? (u).pn % g.csplit : (u).pn) * tstep + (g.csplit ? (size_t)((u).pn / g.csplit) * kcb : (size_t)0))
    const char* cA = PG8_AOF(cur); const char* cB = PG8_BOF(cur);
    S.a_ready(cur);
    if constexpr (SP2) {
        PG8_STAGE(PG8_SB(0, 0), cB, voffB); PG8_STAGE(PG8_SB(0, 1), cB + hstep, voffB); PG8_STAGE(PG8_SA(0, 0), cA, voffA); PG8_STAGE(PG8_SA(0, 1), cA + hstepA, voffA);
        if (wr == 1) PG8_BAR;
        PG8_WAIT_V(2); PG8_BAR;
        PG8_STAGE(PG8_SB(1, 0), cB + kstep, voffB); PG8_STAGE(PG8_SA(1, 0), cA + kstep, voffA); PG8_STAGE(PG8_SB(1, 1), cB + hstep + kstep, voffB);
        PG8_WAIT_V(6); PG8_BAR;
    } else {
        PG8_STAGE(PG8_SB(0, 0), cB, voffB); PG8_STAGE(PG8_SA(0, 0), cA, voffA); PG8_STAGE(PG8_SB(0, 1), cB + hstep, voffB); PG8_STAGE(PG8_SA(0, 1), cA + hstepA, voffA);
        if (wr == 1) PG8_BAR;
        PG8_WAIT_V(4); PG8_BAR;
        PG8_STAGE(PG8_SB(1, 0), cB + kstep, voffB); PG8_STAGE(PG8_SA(1, 0), cA + kstep, voffA); PG8_STAGE(PG8_SB(1, 1), cB + hstep + kstep, voffB);
        PG8_WAIT_V(6); PG8_BAR;
    }
    for (;;) {
        const bool has_next = S.next(ui + 1, nxt);
        const char* nA = has_next ? PG8_AOF(nxt) : cA; const char* nB = has_next ? PG8_BOF(nxt) : cB;
        for (int t = 0; t < nt; t += 2) {
            const bool last = (t == nt - 2);
            const char* a1 = cA + (size_t)(t + 1) * kstep;
            const char* a2 = last ? nA : cA + (size_t)(t + 2) * kstep; const char* b2 = last ? nB : cB + (size_t)(t + 2) * kstep;
            const char* a3 = a2 + kstep; const char* b3 = b2 + kstep;
            if (last && has_next) S.a_ready(nxt);
            if constexpr (SP2) {
            PG8_LDB(B0, 0, 0); PG8_LDB(B1, 0, 1); PG8_SCHED; PG8_LDA(At, 0, 0); PG8_STAGE(PG8_SA(1, 1), a1 + hstepA, voffA);
            PG8_WAIT_V(8); PG8_WAIT_L(0); PG8_BAR; PG8_MMA(0, 0, At, B0); PG8_MMA(0, 1, At, B1); PG8_BAR; PG8_SCHED;
            PG8_LDA(At, 0, 1); PG8_STAGE(PG8_SB(0, 0), b2, voffB); PG8_STAGE(PG8_SB(0, 1), b2 + hstep, voffB); PG8_STAGE(PG8_SA(0, 0), a2, voffA);
            PG8_WAIT_V(8); PG8_WAIT_L(0); PG8_BAR; PG8_MMA(1, 0, At, B0); PG8_MMA(1, 1, At, B1); PG8_BAR; PG8_SCHED;
            PG8_LDB(B0, 1, 0); PG8_LDB(B1, 1, 1); PG8_SCHED; PG8_LDA(At, 1, 0); PG8_STAGE(PG8_SA(0, 1), a2 + hstepA, voffA);
            PG8_WAIT_V(8); PG8_WAIT_L(0); PG8_BAR; PG8_MMA(0, 0, At, B0); PG8_MMA(0, 1, At, B1); PG8_BAR; PG8_SCHED;
            PG8_LDA(At, 1, 1); PG8_STAGE(PG8_SB(1, 0), b3, voffB); PG8_STAGE(PG8_SB(1, 1), b3 + hstep, voffB); PG8_STAGE(PG8_SA(1, 0), a3, voffA);
            PG8_WAIT_V(8); PG8_WAIT_L(0); PG8_BAR; PG8_MMA(1, 0, At, B0); PG8_MMA(1, 1, At, B1); PG8_BAR; PG8_SCHED;
            } else {
            PG8_LDB(B0, 0, 0); PG8_SCHED; PG8_LDA(At, 0, 0); PG8_STAGE(PG8_SA(1, 1), a1 + hstepA, voffA);
            PG8_WAIT_L(8); PG8_BAR; PG8_WAIT_L(0); PG8_MMA(0, 0, At, B0); PG8_BAR; PG8_SCHED;
            PG8_LDB(B1, 0, 1); PG8_STAGE(PG8_SB(0, 0), b2, voffB);
            PG8_BAR; PG8_WAIT_L(0); PG8_MMA(0, 1, At, B1); PG8_BAR;
            PG8_LDA(At, 0, 1); PG8_STAGE(PG8_SA(0, 0), a2, voffA);
            PG8_BAR; PG8_WAIT_L(0); PG8_MMA(1, 0, At, B0); PG8_BAR; PG8_SCHED;
            PG8_STAGE(PG8_SB(0, 1), b2 + hstep, voffB);
            PG8_WAIT_V(6); PG8_BAR; PG8_MMA(1, 1, At, B1); PG8_BAR;
            PG8_LDB(B0, 1, 0); PG8_SCHED; PG8_LDA(At, 1, 0); PG8_STAGE(PG8_SA(0, 1), a2 + hstepA, voffA);
            PG8_WAIT_L(8); PG8_BAR; PG8_WAIT_L(0); PG8_MMA(0, 0, At, B0); PG8_BAR; PG8_SCHED;
            PG8_LDB(B1, 1, 1); PG8_STAGE(PG8_SB(1, 0), b3, voffB);
            PG8_BAR; PG8_WAIT_L(0); PG8_MMA(0, 1, At, B1); PG8_BAR;
            PG8_LDA(At, 1, 1); PG8_STAGE(PG8_SA(1, 0), a3, voffA);
            PG8_BAR; PG8_WAIT_L(0); PG8_MMA(1, 0, At, B0); PG8_BAR; PG8_SCHED;
            PG8_STAGE(PG8_SB(1, 1), b3 + hstep, voffB);
            PG8_WAIT_V(6); PG8_BAR; PG8_MMA(1, 1, At, B1); PG8_BAR;
            }
        }
        if constexpr (ALIGN_EPI) { if (wr == 0) PG8_BAR; }
        if constexpr (!Epi::AFTER_DRAIN) { E(acc, cur, wr, wc, fr, fq); S.done(cur); }
        if (!has_next) break;
#pragma unroll
        for (int a = 0; a < 2; ++a)
#pragma unroll
            for (int b = 0; b < 2; ++b)
#pragma unroll
                for (int m = 0; m < 4; ++m)
#pragma unroll
                    for (int n = 0; n < 2; ++n) acc[a][b][m][n] = (f32x4){0.f, 0.f, 0.f, 0.f};
        cur = nxt; cA = nA; cB = nB; ++ui;
        if constexpr (ALIGN_EPI) { if (wr == 1) PG8_BAR; }
    }
    PG8_WAIT_V(0);
    if constexpr (!ALIGN_EPI) { if (wr == 0) PG8_BAR; }
    PG8_BAR;
    if constexpr (Epi::AFTER_DRAIN) { E.fused(acc, cur, wr, wc, fr, fq, lds, wid, lane); S.done(cur); }
#undef PG8_AOF
#undef PG8_BOF
#undef PG8_SA
#undef PG8_SB
#undef PG8_STAGE
#undef PG8_LDA
#undef PG8_LDB
#undef PG8_MMA
#undef PG8_WAIT_V
#undef PG8_WAIT_L
#undef PG8_BAR
#undef PG8_SCHED
}
}

#define DI __device__ __forceinline__
typedef pg8::bf16_t bf16_t;
typedef pg8::f32x4 f32x4;
typedef pg8::u32x4 u32x4;
typedef unsigned u32x2 __attribute__((ext_vector_type(2)));
#define LAS __attribute__((address_space(3)))

constexpr int DM = 1024, SEQ = 8192, NBATCH = 2, CTXL = 256;
constexpr int RL = NBATCH * SEQ;
constexpr int RT = RL + NBATCH * CTXL;
constexpr int FH = 2816, ABW = 2304;
constexpr float EPS = 1e-6f, LOG2E = 1.4426950408889634f;
constexpr int NWAVES = 8, NTHR = 512;
constexpr int LDS_BYTES = 147456;

constexpr size_t MiB = 1u << 20;
constexpr size_t OFF_MOD = 0;
constexpr size_t OFF_TAB_AB = 147456;
constexpr size_t OFF_TAB_C = 163840;
constexpr size_t OFF_BAR = 196608;
constexpr size_t OFF_KR = 1 * MiB;
constexpr size_t OFF_XSC = 3 * MiB;
constexpr size_t OFF_W = 5 * MiB;
constexpr size_t W_ABIN = OFF_W;
constexpr size_t W_ABOUT = W_ABIN + (size_t)2304 * 1024 * 2;
constexpr size_t W_13 = W_ABOUT + (size_t)1024 * 1024 * 2;
constexpr size_t W_2 = W_13 + (size_t)2 * 5632 * 1024 * 2;
constexpr size_t W_MIN = W_2 + (size_t)2 * 1024 * 2816 * 2;
constexpr size_t W_QB = W_MIN + (size_t)768 * 1024 * 2;
constexpr size_t W_KVB = W_QB + (size_t)1536 * 384 * 2;
constexpr size_t W_MOUT = W_KVB + (size_t)2048 * 256 * 2;
constexpr size_t W_END = W_MOUT + (size_t)1024 * 1024 * 2;
constexpr size_t OFF_HXR = 52 * MiB;
constexpr size_t OFF_YR = 85 * MiB;
constexpr size_t OFF_BIG = 151 * MiB;
constexpr size_t WS_END = OFF_BIG + (size_t)RT * FH * 2;
static_assert(W_END <= OFF_HXR && WS_END <= 256 * MiB, "ws map");
constexpr size_t OFF_TAIL = 242 * MiB;
static_assert(OFF_TAIL >= WS_END && OFF_TAIL + 7 * 2 * MiB <= 256 * MiB, "split-K slices");
constexpr size_t OFF_QL = OFF_HXR, OFF_KVL = OFF_HXR + (size_t)RT * 384 * 2;

#define XB_TMO      128
#define XB_XCNT(j)  (256  + 64 * (j))
#define XB_XSUB(j)  (1280 + 64 * (j))
#define XB_XGEN(j)  (2304 + 64 * (j))
#define XB_TOP      3328
#define XB_TOPGEN   3392
#define XCD_BAR_WORDS 3456
#define XB_SPIN_CAP (1u << 18)

__device__ __forceinline__ unsigned xb_ld(unsigned* p)              { return __hip_atomic_load(p, __ATOMIC_RELAXED, __HIP_MEMORY_SCOPE_AGENT); }
__device__ __forceinline__ unsigned xb_add(unsigned* p, unsigned v) { return __hip_atomic_fetch_add(p, v, __ATOMIC_RELAXED, __HIP_MEMORY_SCOPE_AGENT); }
__device__ __forceinline__ unsigned xb_xcc_id() { return (unsigned)__builtin_amdgcn_s_getreg((3 << 11) | 20) & 0xFu; }
#define XB_SPIN(cond, bar) do { unsigned _sp = 0; while (cond) { __builtin_amdgcn_s_sleep(1); \
    if ((++_sp & 255u) == 0u) { if (xb_ld(&(bar)[XB_TMO])) break; if (_sp > XB_SPIN_CAP) { atomicAdd(&(bar)[XB_TMO], 1u); break; } } } } while (0)

struct XcdBarrier {
    unsigned* bar; unsigned x;
    volatile LAS unsigned* st;
};

__device__ __forceinline__ XcdBarrier xcd_barrier_post(unsigned* bar, volatile LAS unsigned* st) {
    XcdBarrier b; b.bar = bar; b.x = xb_xcc_id(); b.st = st;
    if (threadIdx.x == 0) (void)xb_add(&bar[XB_XCNT(b.x)], 1u);
    return b;
}
__device__ __forceinline__ void xcd_barrier_complete(unsigned* bar, unsigned x, unsigned& nloc, unsigned& nx) {
    const unsigned G = gridDim.x * gridDim.y * gridDim.z;
    unsigned sum, cnt, mine, sp = 0u;
    for (;;) {
        sum = 0u; cnt = 0u; mine = 0u;
#pragma unroll
        for (unsigned j = 0; j < 16; ++j) { const unsigned c = xb_ld(&bar[XB_XCNT(j)]); sum += c; cnt += (c > 0u) ? 1u : 0u; mine = (j == x) ? c : mine; }
        if (sum == G) break;
        __builtin_amdgcn_s_sleep(1);
        if ((++sp & 255u) == 0u) { if (xb_ld(&bar[XB_TMO])) break; if (sp > XB_SPIN_CAP) { atomicAdd(&bar[XB_TMO], 1u); break; } }
    }
    nloc = mine > 0u ? mine : 1u; nx = cnt > 0u ? cnt : 1u;
}

__device__ __forceinline__ void xcd_barrier(const XcdBarrier& b) {
    asm volatile("s_waitcnt vmcnt(0)" ::: "memory");
    __syncthreads();
    if (threadIdx.x == 0) {
        unsigned* bar = b.bar;
        __builtin_amdgcn_s_waitcnt(0);
        unsigned nloc = b.st[0], nx = b.st[1];
        if (nloc == 0u) { xcd_barrier_complete(bar, b.x, nloc, nx); b.st[0] = nloc; b.st[1] = nx; }
        const unsigned old = xb_add(&bar[XB_XSUB(b.x)], 1u);
        const unsigned gen = old / nloc;
        if (old + 1u == (gen + 1u) * nloc) {
            __builtin_amdgcn_fence(__ATOMIC_RELEASE, "agent");
            asm volatile("s_waitcnt vmcnt(0)" ::: "memory");
            const unsigned og = xb_add(&bar[XB_TOP], 1u);
            const unsigned tg = og / nx;
            if (og + 1u == (tg + 1u) * nx) xb_add(&bar[XB_TOPGEN], 1u);
            else XB_SPIN(xb_ld(&bar[XB_TOPGEN]) == tg, bar);
            __builtin_amdgcn_fence(__ATOMIC_ACQUIRE, "agent");
            xb_add(&bar[XB_XGEN(b.x)], 1u);
            asm volatile("s_waitcnt vmcnt(0)" ::: "memory");
        } else {
            XB_SPIN(xb_ld(&bar[XB_XGEN(b.x)]) == gen, bar);
            __builtin_amdgcn_fence(__ATOMIC_ACQUIRE, "agent");
            asm volatile("s_waitcnt vmcnt(0)" ::: "memory");
        }
    }
    __syncthreads();
}

constexpr int LDS_ST_OFF = 131072 + 512;

struct EpiF32 {
    static constexpr bool PERM = false, AFTER_DRAIN = false;
    float* O; int ldc;
    DI void operator()(const f32x4 (&acc)[2][2][4][2], const pg8::Unit& u, int wr, int wc, int fr_, int fq_) const {
        int fr = fr_, fq = fq_; asm volatile("" : "+v"(fr), "+v"(fq));
        const int row0 = u.pm * 256 + wr * 64 + fr, col0 = u.pn * 256 + wc * 32 + 4 * fq;
#pragma unroll
        for (int ai = 0; ai < 2; ++ai)
#pragma unroll
            for (int m = 0; m < 4; ++m) { float* rowp = O + (size_t)(row0 + ai * 128 + m * 16) * ldc + col0;
#pragma unroll
                for (int bj = 0; bj < 2; ++bj)
#pragma unroll
                    for (int n = 0; n < 2; ++n) *(f32x4*)(rowp + bj * 128 + n * 16) = acc[ai][bj][m][n]; }
    }
};
struct EpiBf16P {
    static constexpr bool PERM = true, AFTER_DRAIN = false;
    bf16_t* O; int ldc;
    DI void operator()(const f32x4 (&acc)[2][2][4][2], const pg8::Unit& u, int wr, int wc, int fr_, int fq_) const {
        int fr = fr_, fq = fq_; asm volatile("" : "+v"(fr), "+v"(fq));
        const int row0 = u.pm * 256 + wr * 64 + fr, col0 = u.pn * 256 + wc * 32 + 8 * fq;
#pragma unroll
        for (int ai = 0; ai < 2; ++ai)
#pragma unroll
            for (int m = 0; m < 4; ++m) { bf16_t* rowp = O + (size_t)(row0 + ai * 128 + m * 16) * ldc + col0;
#pragma unroll
                for (int bj = 0; bj < 2; ++bj) { const f32x4 v0 = acc[ai][bj][m][0], v1 = acc[ai][bj][m][1]; u32x4 w;
                    w.x = pg8::cvt_pk_bf16(v0[0], v0[1]); w.y = pg8::cvt_pk_bf16(v0[2], v0[3]); w.z = pg8::cvt_pk_bf16(v1[0], v1[1]); w.w = pg8::cvt_pk_bf16(v1[2], v1[3]);
                    *(u32x4*)(rowp + bj * 128) = w; } }
    }
};
DI float silu_f(float g) { return g / (1.0f + __expf(-g)); }
struct EpiSwiGLU {
    static constexpr bool PERM = true, AFTER_DRAIN = false;
    bf16_t* O; int ldc;
    DI void operator()(const f32x4 (&acc)[2][2][4][2], const pg8::Unit& u, int wr, int wc, int fr_, int fq_) const {
        int fr = fr_, fq = fq_; asm volatile("" : "+v"(fr), "+v"(fq));
        const int row0 = u.pm * 256 + wr * 64 + fr, col0 = u.pn * 128 + wc * 32 + 8 * fq;
#pragma unroll
        for (int ai = 0; ai < 2; ++ai)
#pragma unroll
            for (int m = 0; m < 4; ++m) { bf16_t* rowp = O + (size_t)(row0 + ai * 128 + m * 16) * ldc + col0;
                const f32x4 g0 = acc[ai][0][m][0], g1 = acc[ai][0][m][1], u0 = acc[ai][1][m][0], u1 = acc[ai][1][m][1]; u32x4 w;
                w.x = pg8::cvt_pk_bf16(silu_f(g0[0]) * u0[0], silu_f(g0[1]) * u0[1]); w.y = pg8::cvt_pk_bf16(silu_f(g0[2]) * u0[2], silu_f(g0[3]) * u0[3]);
                w.z = pg8::cvt_pk_bf16(silu_f(g1[0]) * u1[0], silu_f(g1[1]) * u1[1]); w.w = pg8::cvt_pk_bf16(silu_f(g1[2]) * u1[2], silu_f(g1[3]) * u1[3]);
                *(u32x4*)rowp = w; }
    }
};
typedef float f32x2v __attribute__((ext_vector_type(2)));
struct EpiQKV {
    static constexpr bool PERM = false, AFTER_DRAIN = false;
    bf16_t* O; const float* tab;
    DI void operator()(const f32x4 (&acc)[2][2][4][2], const pg8::Unit& u, int wr, int wc, int fr_, int fq_) const {
        int fr = fr_, fq = fq_; asm volatile("" : "+v"(fr), "+v"(fq));
        const int row0 = u.pm * 256 + wr * 64 + fr;
#pragma unroll
        for (int bj = 0; bj < 2; ++bj) {
            const int cb = u.pn * 256 + bj * 128;
            const bool rope = (cb < 1152) || (cb >= 1280 && cb < 1792);
            const float sc = cb < 1024 ? 0.125f * LOG2E : 1.0f;
#pragma unroll
            for (int ai = 0; ai < 2; ++ai)
#pragma unroll
                for (int m = 0; m < 4; ++m) {
                    const int row = row0 + ai * 128 + m * 16;
                    f32x4 v0 = acc[ai][bj][m][0], v1 = acc[ai][bj][m][1];
                    if (rope && row < RL) {
                        const int t = row & (SEQ - 1), pos = (wc & 1) ? (t & 63) : (t >> 6);
                        const float* tp = tab + (size_t)(pos * 16 + 4 * fq) * 2;
                        const f32x4 cs01 = *(const f32x4*)tp, cs23 = *(const f32x4*)(tp + 4);
                        const f32x4 cs = {cs01[0], cs01[2], cs23[0], cs23[2]}, sn = {cs01[1], cs01[3], cs23[1], cs23[3]};
                        const f32x4 o0 = v0 * cs - v1 * sn, o1 = v1 * cs + v0 * sn; v0 = o0; v1 = o1;
                    }
                    v0 = v0 * sc; v1 = v1 * sc;
                    bf16_t* p = O + (size_t)row * ABW + cb + wc * 32 + 4 * fq;
                    u32x2 w0, w1; w0.x = pg8::cvt_pk_bf16(v0[0], v0[1]); w0.y = pg8::cvt_pk_bf16(v0[2], v0[3]); w1.x = pg8::cvt_pk_bf16(v1[0], v1[1]); w1.y = pg8::cvt_pk_bf16(v1[2], v1[3]);
                    *(u32x2*)p = w0; *(u32x2*)(p + 16) = w1;
                }
        }
    }
};
struct EpiMlaQ {
    static constexpr bool PERM = false, AFTER_DRAIN = false;
    bf16_t* O; const float* tab;
    DI void operator()(const f32x4 (&acc)[2][2][4][2], const pg8::Unit& u, int wr, int wc, int fr_, int fq_) const {
        int fr = fr_, fq = fq_; asm volatile("" : "+v"(fr), "+v"(fq));
        const int row0 = u.pm * 256 + wr * 64 + fr;
        const float sc = 0.10206207261596575f * LOG2E;
#pragma unroll
        for (int bj = 0; bj < 2; ++bj) {
            const int cb = u.pn * 256 + bj * 128, G = (cb >> 5) + wc;
            const bool rope = (G % 3) == 2;
#pragma unroll
            for (int ai = 0; ai < 2; ++ai)
#pragma unroll
                for (int m = 0; m < 4; ++m) {
                    const int row = row0 + ai * 128 + m * 16;
                    f32x4 v0 = acc[ai][bj][m][0], v1 = acc[ai][bj][m][1];
                    if (rope) {
                        const int t = row & (SEQ - 1), pos = (fq & 2) ? (t & 63) : (t >> 6);
                        const float* tp = tab + (size_t)(pos * 8 + 4 * (fq & 1)) * 2;
                        const f32x4 cs01 = *(const f32x4*)tp, cs23 = *(const f32x4*)(tp + 4);
                        const f32x4 cs = {cs01[0], cs01[2], cs23[0], cs23[2]}, sn = {cs01[1], cs01[3], cs23[1], cs23[3]};
                        const f32x4 o0 = v0 * cs - v1 * sn, o1 = v1 * cs + v0 * sn; v0 = o0; v1 = o1;
                    }
                    v0 = v0 * sc; v1 = v1 * sc;
                    bf16_t* p = O + (size_t)row * 1536 + cb + wc * 32 + 4 * fq;
                    u32x2 w0, w1; w0.x = pg8::cvt_pk_bf16(v0[0], v0[1]); w0.y = pg8::cvt_pk_bf16(v0[2], v0[3]); w1.x = pg8::cvt_pk_bf16(v1[0], v1[1]); w1.y = pg8::cvt_pk_bf16(v1[2], v1[3]);
                    *(u32x2*)p = w0; *(u32x2*)(p + 16) = w1;
                }
        }
    }
};

template <class Epi>
DI void run_gemm(LAS unsigned char* lds, const bf16_t* A, int lda, const bf16_t* Bt, int M, int N, int K, const Epi& E) {
    int bx_ = blockIdx.x; asm volatile("" : "+s"(bx_));
    asm volatile("" : "+s"(M), "+s"(N), "+s"(K), "+s"(lda));
    pg8::Gemm g{A, Bt, M, N, K, lda, K, 0}; pg8::StaticOrder S; S.init(M, N, (int)gridDim.x, bx_);
    pg8::gemm_phase<Epi, pg8::StaticOrder, true, true>(lds, g, S, E);
}

struct EpiSplitF32 {
    static constexpr bool PERM = false, AFTER_DRAIN = false;
    float* P0; float* P1; int n0; int csplit;
    DI void operator()(const f32x4 (&acc)[2][2][4][2], const pg8::Unit& u, int wr, int wc, int fr_, int fq_) const {
        int fr = fr_, fq = fq_; asm volatile("" : "+v"(fr), "+v"(fq));
        const int chunk = u.pn / csplit;
        float* O = chunk < n0 ? P0 + (size_t)chunk * (512 * 1024) : P1 + (size_t)(chunk - n0) * (512 * 1024);
        const int row0 = u.pm * 256 + wr * 64 + fr, col0 = (u.pn % csplit) * 256 + wc * 32 + 4 * fq;
#pragma unroll
        for (int ai = 0; ai < 2; ++ai)
#pragma unroll
            for (int m = 0; m < 4; ++m) { float* rowp = O + (size_t)(row0 + ai * 128 + m * 16) * 1024 + col0;
#pragma unroll
                for (int bj = 0; bj < 2; ++bj)
#pragma unroll
                    for (int n = 0; n < 2; ++n) *(f32x4*)(rowp + bj * 128 + n * 16) = acc[ai][bj][m][n]; }
    }
};
DI void run_gemm_splitk(LAS unsigned char* lds, const bf16_t* A, int lda, const bf16_t* Bt, int ldb, int M, int Nreal, int Kc, int nsplit, float* P0, float* P1, int n0) {
    int bx_ = blockIdx.x; asm volatile("" : "+s"(bx_));
    int Nv = Nreal * nsplit; asm volatile("" : "+s"(M), "+s"(Nv), "+s"(Kc), "+s"(lda), "+s"(ldb));
    pg8::Gemm g{A, Bt, M, Nv, Kc, lda, ldb, Nreal / 256}; pg8::StaticOrder S; S.init(M, Nv, (int)gridDim.x, bx_);
    EpiSplitF32 E{P0, P1, n0, Nreal / 256};
    pg8::gemm_phase<EpiSplitF32, pg8::StaticOrder, true, true>(lds, g, S, E);
}

namespace att {
using bf16x8 = __attribute__((ext_vector_type(8))) short;
using s16x4 = __attribute__((ext_vector_type(4))) short;
using f32x16 = __attribute__((ext_vector_type(16))) float;
#define SBAR() __builtin_amdgcn_sched_barrier(0)
#define LBAR() asm volatile("s_waitcnt lgkmcnt(0)\n\ts_barrier" ::: "memory")
constexpr float THR = 11.5f, NEGBIG = -1e30f;
DI int crow(int r, int hi) { return (r & 3) + 8 * (r >> 2) + 4 * hi; }
DI unsigned cvtpk(float lo, float hi) { unsigned r; asm volatile("v_cvt_pk_bf16_f32 %0, %1, %2" : "=v"(r) : "v"(lo), "v"(hi)); return r; }
DI int kswz64(int row, int colB) { return row * 128 + (colB ^ (((row >> 1) & 7) << 4)); }
DI int kswz32(int row, int chunk) { return row * 64 + ((chunk ^ ((row >> 2) & 3)) << 4); }

DI void partialSM(f32x16& p0, f32x16& p1, float& m_reg, float& mn, float& alpha) {
    float pmax = p0[0];
#pragma unroll
    for (int r = 1; r < 16; ++r) pmax = fmaxf(pmax, p0[r]);
#pragma unroll
    for (int r = 0; r < 16; ++r) pmax = fmaxf(pmax, p1[r]);
    { auto rr = __builtin_amdgcn_permlane32_swap(__float_as_uint(pmax), __float_as_uint(pmax), false, false);
      pmax = fmaxf(__uint_as_float(rr[0]), __uint_as_float(rr[1])); }
    if (__builtin_expect(__all(pmax - m_reg <= THR), 1)) { mn = m_reg; alpha = 1.f; }
    else { mn = fmaxf(m_reg, pmax); alpha = __builtin_amdgcn_exp2f(m_reg - mn); m_reg = mn; }
#pragma unroll
    for (int r = 0; r < 16; ++r) { p0[r] = p0[r] - mn; p1[r] = p1[r] - mn; }
#pragma unroll
    for (int r = 0; r < 16; ++r) p0[r] = __builtin_amdgcn_exp2f(p0[r]);
}
DI void finishSM(f32x16& p0, f32x16& p1, float alpha, float& l_reg, bf16x8& pa0, bf16x8& pa1, bf16x8& pa2, bf16x8& pa3) {
#pragma unroll
    for (int r = 0; r < 16; ++r) p1[r] = __builtin_amdgcn_exp2f(p1[r]);
    float ps = 0;
#pragma unroll
    for (int r = 0; r < 16; ++r) ps += p0[r];
#pragma unroll
    for (int r = 0; r < 16; ++r) ps += p1[r];
    { auto rr = __builtin_amdgcn_permlane32_swap(__float_as_uint(ps), __float_as_uint(ps), false, false);
      ps = __uint_as_float(rr[0]) + __uint_as_float(rr[1]); }
    l_reg = l_reg * alpha + ps;
#define PK4(P, BASE, OUT) do { u32x4 w = {cvtpk(P[BASE + 0], P[BASE + 1]), cvtpk(P[BASE + 2], P[BASE + 3]), cvtpk(P[BASE + 4], P[BASE + 5]), cvtpk(P[BASE + 6], P[BASE + 7])}; \
    OUT = __builtin_bit_cast(bf16x8, w); } while (0)
    PK4(p0, 0, pa0); PK4(p0, 8, pa1); PK4(p1, 0, pa2); PK4(p1, 8, pa3);
#undef PK4
}
template <int DK2>
DI void qkt(f32x16& p0, f32x16& p1, const char* K1b, const char* K2b, const bf16x8* qr, int r32, int hi) {
    p0 = f32x16{}; p1 = f32x16{};
#pragma unroll
    for (int d0 = 0; d0 < 4; ++d0) { const int cb = d0 * 32 + hi * 16;
        const bf16x8 b0 = *reinterpret_cast<const bf16x8*>(K1b + kswz64(r32, cb));
        const bf16x8 b1 = *reinterpret_cast<const bf16x8*>(K1b + kswz64(32 + r32, cb));
        p0 = __builtin_amdgcn_mfma_f32_32x32x16_bf16(b0, qr[d0], p0, 0, 0, 0);
        p1 = __builtin_amdgcn_mfma_f32_32x32x16_bf16(b1, qr[d0], p1, 0, 0, 0); }
    if constexpr (DK2 > 0) {
#pragma unroll
        for (int d0 = 0; d0 < 2; ++d0) { const int ch = d0 * 2 + hi;
            const bf16x8 b0 = *reinterpret_cast<const bf16x8*>(K2b + kswz32(r32, ch));
            const bf16x8 b1 = *reinterpret_cast<const bf16x8*>(K2b + kswz32(32 + r32, ch));
            p0 = __builtin_amdgcn_mfma_f32_32x32x16_bf16(b0, qr[4 + d0], p0, 0, 0, 0);
            p1 = __builtin_amdgcn_mfma_f32_32x32x16_bf16(b1, qr[4 + d0], p1, 0, 0, 0); }
    }
}
DI void wmask(f32x16& p0, f32x16& p1, int kp, int qp, int hi) {
#pragma unroll
    for (int r = 0; r < 16; ++r) { const int d0 = kp + crow(r, hi) - qp, d1 = d0 + 32;
        if (d0 > 128 || d0 < -128) p0[r] = NEGBIG;
        if (d1 > 128 || d1 < -128) p1[r] = NEGBIG; }
}
template <int NC> DI int v_st(int k, int c) { const int kk = k;     return ((kk >> 3) * NC + (c >> 5)) * 512 + ((kk & 7) * 32 + (c & 31)) * 2; }
DI int v_rd_base(int lane) { return ((lane & 3) << 3) | (((lane >> 2) & 3) << 6) | (((lane >> 4) & 1) << 5) | (((lane >> 5) & 1) << 8); }
typedef short v4i16_t __attribute__((ext_vector_type(4)));
DI s16x4 vtr(int addr) { return __builtin_bit_cast(s16x4, __builtin_amdgcn_ds_read_tr16_b64_v4i16((LAS v4i16_t*)(unsigned)addr)); }
template <int NC, int DB> DI void pv_two(f32x16* o, int vb, bf16x8 pa0, bf16x8 pa1, bf16x8 pa2, bf16x8 pa3) {
    constexpr int KS = 2 * NC * 512, HF = NC * 512;
    s16x4 vl[2][4], vh[2][4];
#pragma unroll
    for (int d = 0; d < 2; ++d)
#pragma unroll
        for (int ks = 0; ks < 4; ++ks) { vl[d][ks] = vtr(vb + (DB + d) * 512 + ks * KS); vh[d][ks] = vtr(vb + (DB + d) * 512 + ks * KS + HF); }
#define PKV(L, H) (bf16x8){L[0], L[1], L[2], L[3], H[0], H[1], H[2], H[3]}
#pragma unroll
    for (int d = 0; d < 2; ++d) {
        o[DB + d] = __builtin_amdgcn_mfma_f32_32x32x16_bf16(pa0, PKV(vl[d][0], vh[d][0]), o[DB + d], 0, 0, 0);
        o[DB + d] = __builtin_amdgcn_mfma_f32_32x32x16_bf16(pa1, PKV(vl[d][1], vh[d][1]), o[DB + d], 0, 0, 0);
        o[DB + d] = __builtin_amdgcn_mfma_f32_32x32x16_bf16(pa2, PKV(vl[d][2], vh[d][2]), o[DB + d], 0, 0, 0);
        o[DB + d] = __builtin_amdgcn_mfma_f32_32x32x16_bf16(pa3, PKV(vl[d][3], vh[d][3]), o[DB + d], 0, 0, 0); }
#undef PKV
}
template <int NC> DI void pv_all(f32x16* o, int vb, bf16x8 pa0, bf16x8 pa1, bf16x8 pa2, bf16x8 pa3) {
    pv_two<NC, 0>(o, vb, pa0, pa1, pa2, pa3);
    if constexpr (NC == 4) pv_two<NC, 2>(o, vb, pa0, pa1, pa2, pa3);
}

struct Job {
    const bf16_t* Q; int ldq;
    const bf16_t* K1; int ldk1;
    const bf16_t* K2; int ldk2;
    const bf16_t* V; int ldv;
    int row1, nt1, row2, nt2;
    int win, qpos0, kpos0;
    float m0, l0;
    int omode;
    bf16_t* Ob; int ldo;
    float* Of; int ldf;
    float lam; const float* subg;
};

template <int DK2, int DV>
DI void unit(const Job& J, char* lds) {
    constexpr int NC = DV / 32, NQ = (64 + DK2) / 16;
    constexpr int KB1 = 8192, KB2 = 4096, VBY = 64 * DV * 2;
    int tid = threadIdx.x; asm volatile("" : "+v"(tid));
    const int wid = tid >> 6, lane = tid & 63, r32 = lane & 31, hi = lane >> 5;
    char* K1s = lds; char* K2s = lds + 2 * KB1; char* Vs = lds + 2 * KB1 + 2 * KB2;
    float* wsf = (float*)(lds + 2 * KB1 + 2 * KB2 + 2 * VBY) + wid * 64; float* li_l = wsf; float* al_l = wsf + 32;
    float m_reg = J.m0, l_reg = J.l0; f32x16 o[NC]; bf16x8 qr[NQ];
#pragma unroll
    for (int d = 0; d < NC; ++d) o[d] = f32x16{};
    const bf16_t* Qw = J.Q + (size_t)(wid * 32 + r32) * J.ldq + hi * 8;
#pragma unroll
    for (int d0 = 0; d0 < NQ; ++d0) qr[d0] = *reinterpret_cast<const bf16x8*>(Qw + d0 * 16);
    const int kr = tid >> 3, kc = (tid & 7) * 8;
    const int k2r = (tid >> 2) & 63, k2c = (tid & 3) * 8;
    const int vr = (DV == 64) ? (tid >> 3) : (tid >> 4), vc = (DV == 64) ? (tid & 7) * 8 : (tid & 15) * 8;
    const int k1off = kswz64(kr, kc * 2), k2off = kswz32(k2r, tid & 3);
    const int vst0 = v_st<NC>(vr, vc), vst1 = v_st<NC>(32 + vr, vc);
    const int vb0 = (int)(uintptr_t)Vs + v_rd_base(lane);
    const int NT = J.nt1 + J.nt2;
    const int qp = J.qpos0 + wid * 32 + r32;
    struct { bf16x8 k1, k2, v0, v1; } sr_[2];
#define TROW(t) ((t) < J.nt1 ? J.row1 + 64 * (t) : J.row2 + 64 * ((t) - J.nt1))
#define SLOAD(i, t) do { const size_t rw_ = (size_t)TROW(t); \
        sr_[i].k1 = *reinterpret_cast<const bf16x8*>(J.K1 + (rw_ + kr) * J.ldk1 + kc); \
        if (DK2 > 0 && tid < 256) sr_[i].k2 = *reinterpret_cast<const bf16x8*>(J.K2 + (rw_ + k2r) * J.ldk2 + k2c); \
        sr_[i].v0 = *reinterpret_cast<const bf16x8*>(J.V + (rw_ + vr) * J.ldv + vc); \
        if (DV == 128) sr_[i].v1 = *reinterpret_cast<const bf16x8*>(J.V + (rw_ + 32 + vr) * J.ldv + vc); } while (0)
#define SWRITE(b, i) do { *reinterpret_cast<bf16x8*>(K1s + (b) * KB1 + k1off) = sr_[i].k1; \
        if (DK2 > 0 && tid < 256) *reinterpret_cast<bf16x8*>(K2s + (b) * KB2 + k2off) = sr_[i].k2; \
        *reinterpret_cast<bf16x8*>(Vs + (b) * VBY + vst0) = sr_[i].v0; \
        if (DV == 128) *reinterpret_cast<bf16x8*>(Vs + (b) * VBY + vst1) = sr_[i].v1; } while (0)
#define RESC(a) do { if (__any((a) < 1.f)) { if (hi == 0) al_l[r32] = (a); asm volatile("s_waitcnt lgkmcnt(0)" ::: "memory"); \
        _Pragma("unroll") for (int d = 0; d < NC; ++d) _Pragma("unroll") for (int r = 0; r < 16; ++r) o[d][r] *= al_l[crow(r, hi)]; } } while (0)
#define MASK(P0, P1, t) do { if (J.win && (t) < J.nt1) wmask(P0, P1, J.kpos0 + 64 * (t), qp, hi); } while (0)
    f32x16 pA0, pA1, pB0, pB1; float mnA, mnB, alA, alB; bf16x8 pa0, pa1, pa2, pa3;
    SLOAD(0, 0); SWRITE(0, 0); LBAR();
    qkt<DK2>(pA0, pA1, K1s, K2s, qr, r32, hi); MASK(pA0, pA1, 0); partialSM(pA0, pA1, m_reg, mnA, alA);
    SLOAD(1, 1); if (2 < NT) SLOAD(0, 2);
    SWRITE(1, 1); LBAR();
    for (int j = 1; j + 1 < NT; j += 2) {
        SBAR(); qkt<DK2>(pB0, pB1, K1s + KB1, K2s + KB2, qr, r32, hi); MASK(pB0, pB1, j);
        finishSM(pA0, pA1, alA, l_reg, pa0, pa1, pa2, pa3); SBAR();
        SLOAD(1, j + 2); SBAR();
        pv_all<NC>(o, vb0, pa0, pa1, pa2, pa3); partialSM(pB0, pB1, m_reg, mnB, alB);
        LBAR(); SWRITE(0, 0);
        RESC(alB); LBAR();
        SBAR(); qkt<DK2>(pA0, pA1, K1s, K2s, qr, r32, hi); MASK(pA0, pA1, j + 1);
        finishSM(pB0, pB1, alB, l_reg, pa0, pa1, pa2, pa3); SBAR();
        if (j + 3 < NT) SLOAD(0, j + 3); SBAR();
        pv_all<NC>(o, vb0 + VBY, pa0, pa1, pa2, pa3); partialSM(pA0, pA1, m_reg, mnA, alA);
        LBAR(); SWRITE(1, 1);
        RESC(alA); LBAR();
    }
    SBAR(); qkt<DK2>(pB0, pB1, K1s + KB1, K2s + KB2, qr, r32, hi); MASK(pB0, pB1, NT - 1);
    finishSM(pA0, pA1, alA, l_reg, pa0, pa1, pa2, pa3); SBAR();
    pv_all<NC>(o, vb0, pa0, pa1, pa2, pa3); partialSM(pB0, pB1, m_reg, mnB, alB);
    LBAR(); RESC(alB);
    finishSM(pB0, pB1, alB, l_reg, pa0, pa1, pa2, pa3); SBAR();
    pv_all<NC>(o, vb0 + VBY, pa0, pa1, pa2, pa3);
    if (hi == 0) li_l[r32] = l_reg; asm volatile("s_waitcnt lgkmcnt(0)" ::: "memory");
    int tide = tid; asm volatile("" : "+v"(tide));
    const int r32e = tide & 31, hie = (tide >> 5) & 1, wide = tide >> 6;
    float rli[16];
#pragma unroll
    for (int r = 0; r < 16; ++r) rli[r] = 1.0f / li_l[crow(r, hie)];
    if (J.omode == 0) {
        bf16_t* Ow = J.Ob + (unsigned)((wide * 32 + 4 * hie) * J.ldo + r32e);
#pragma unroll
        for (int r = 0; r < 16; ++r) { const unsigned ro = (unsigned)(((r & 3) + 8 * (r >> 2)) * J.ldo);
#pragma unroll
            for (int d0 = 0; d0 < NC; ++d0) Ow[ro + d0 * 32] = (bf16_t)(cvtpk(o[d0][r] * rli[r], 0.f) & 0xffffu); }
    } else if (J.omode == 1) {
        float* Ow = J.Of + (unsigned)((wide * 32 + 4 * hie) * J.ldf + r32e);
#pragma unroll
        for (int r = 0; r < 16; ++r) { const unsigned ro = (unsigned)(((r & 3) + 8 * (r >> 2)) * J.ldf);
#pragma unroll
            for (int d0 = 0; d0 < NC; ++d0) Ow[ro + d0 * 32] = o[d0][r] * rli[r]; }
    } else {
        const float* Fw = J.Of + (unsigned)((wide * 32 + 4 * hie) * J.ldf + r32e); bf16_t* Ow = J.Ob + (unsigned)((wide * 32 + 4 * hie) * J.ldo + r32e);
        float gv[NC];
#pragma unroll
        for (int d0 = 0; d0 < NC; ++d0) gv[d0] = J.subg[d0 * 32 + r32e] * 0.8f;
#pragma unroll
        for (int r = 0; r < 16; ++r) { const unsigned rf = (unsigned)(((r & 3) + 8 * (r >> 2)) * J.ldf), ro = (unsigned)(((r & 3) + 8 * (r >> 2)) * J.ldo); float val[NC]; float ss = 0.f;
#pragma unroll
            for (int d0 = 0; d0 < NC; ++d0) { val[d0] = Fw[rf + d0 * 32] - J.lam * (o[d0][r] * rli[r]); ss += val[d0] * val[d0]; }
            ss += __shfl_xor(ss, 1); ss += __shfl_xor(ss, 2); ss += __shfl_xor(ss, 4); ss += __shfl_xor(ss, 8); ss += __shfl_xor(ss, 16);
            const float rstd = 1.0f / sqrtf(ss * (1.0f / (32 * NC)) + EPS);
#pragma unroll
            for (int d0 = 0; d0 < NC; ++d0) Ow[ro + d0 * 32] = (bf16_t)(cvtpk(val[d0] * rstd * gv[d0], 0.f) & 0xffffu);
            asm volatile("" ::: "memory"); }
    }
#undef TROW
#undef SLOAD
#undef SWRITE
#undef RESC
#undef MASK
}
#undef SBAR
#undef LBAR
}

DI float wave_sum(float v) {
#pragma unroll
    for (int o = 1; o < 64; o <<= 1) v += __shfl_xor(v, o);
    return v;
}
DI unsigned pk2(float lo, float hi) { return pg8::cvt_pk_bf16(lo, hi); }

struct RowOp {
    const float* rin_lat; const float* rin_ctx;
    const float* Y; const float* gY; const float* gate;
    float* rout_lat; float* rout_ctx;
    const float* gN; const float* shift; const float* scale; bf16_t* H;
    int nrows;
    const float* yp0; int nsplit;
};
DI void rowop_phase(const RowOp& P, int gw, int ngw, int lane) {
    for (int row = gw; row < P.nrows; row += ngw) {
        const int g = row < SEQ ? 0 : (row < RL ? 1 : 2);
        const float* xin = row < RL ? P.rin_lat + (size_t)row * DM : P.rin_ctx + (size_t)(row - RL) * DM;
        f32x4 x[4];
#pragma unroll
        for (int j = 0; j < 4; ++j) x[j] = *(const f32x4*)(xin + 4 * lane + 256 * j);
        if (P.Y) {
            f32x4 y[4]; float ss = 0.f;
            if (P.nsplit > 0 && row >= RL) {
#pragma unroll
                for (int j = 0; j < 4; ++j) y[j] = (f32x4){0.f, 0.f, 0.f, 0.f};
                for (int c = 0; c < P.nsplit; ++c) { const float* sl = P.yp0 + (size_t)c * (512 * 1024) + (size_t)(row - RL) * DM + 4 * lane;
#pragma unroll
                    for (int j = 0; j < 4; ++j) y[j] = y[j] + *(const f32x4*)(sl + 256 * j); }
            } else {
#pragma unroll
                for (int j = 0; j < 4; ++j) y[j] = *(const f32x4*)(P.Y + (size_t)row * DM + 4 * lane + 256 * j);
            }
#pragma unroll
            for (int j = 0; j < 4; ++j) ss += (y[j][0] * y[j][0] + y[j][1] * y[j][1]) + (y[j][2] * y[j][2] + y[j][3] * y[j][3]);
            const float rstd = 1.0f / sqrtf(wave_sum(ss) * (1.0f / DM) + EPS);
#pragma unroll
            for (int j = 0; j < 4; ++j) { const f32x4 gy = *(const f32x4*)(P.gY + 4 * lane + 256 * j), gt = *(const f32x4*)(P.gate + g * 6144 + 4 * lane + 256 * j);
                x[j] = x[j] + gt * ((y[j] * rstd) * gy); }
        }
        float* xo = row < RL ? (P.rout_lat ? P.rout_lat + (size_t)row * DM : nullptr) : (P.rout_ctx ? P.rout_ctx + (size_t)(row - RL) * DM : nullptr);
        if (xo) {
#pragma unroll
            for (int j = 0; j < 4; ++j) *(f32x4*)(xo + 4 * lane + 256 * j) = x[j];
        }
        if (P.H) {
            float ss = 0.f;
#pragma unroll
            for (int j = 0; j < 4; ++j) ss += (x[j][0] * x[j][0] + x[j][1] * x[j][1]) + (x[j][2] * x[j][2] + x[j][3] * x[j][3]);
            const float rstd = 1.0f / sqrtf(wave_sum(ss) * (1.0f / DM) + EPS);
#pragma unroll
            for (int j = 0; j < 4; ++j) { const int c = 4 * lane + 256 * j;
                const f32x4 gn = *(const f32x4*)(P.gN + c), sh = *(const f32x4*)(P.shift + g * 6144 + c), sc = *(const f32x4*)(P.scale + g * 6144 + c);
                const f32x4 h = ((x[j] * rstd) * gn) * (sc + 1.0f) + sh;
                u32x2 w; w.x = pk2(h[0], h[1]); w.y = pk2(h[2], h[3]);
                *(u32x2*)(P.H + (size_t)row * DM + c) = w; }
        }
    }
}
DI void mla_prep_phase(const float* P1, const float* qg, const float* kvg, const float* tabc, bf16_t* QL, bf16_t* KVL, bf16_t* KR, int gw, int ngw, int lane) {
    for (int row = gw; row < RT; row += ngw) {
        const float* p = P1 + (size_t)row * 768 + 4 * lane;
        const f32x4 v0 = *(const f32x4*)p, v1 = *(const f32x4*)(p + 256), v2 = *(const f32x4*)(p + 512);
        const float s0 = (v0[0] * v0[0] + v0[1] * v0[1]) + (v0[2] * v0[2] + v0[3] * v0[3]);
        const float s1 = (v1[0] * v1[0] + v1[1] * v1[1]) + (v1[2] * v1[2] + v1[3] * v1[3]);
        const float s2 = (v2[0] * v2[0] + v2[1] * v2[1]) + (v2[2] * v2[2] + v2[3] * v2[3]);
        const float ssq = wave_sum(s0 + (lane < 32 ? s1 : 0.f));
        const float sskv = wave_sum((lane >= 32 ? s1 : 0.f) + (lane < 32 ? s2 : 0.f));
        const float rq = 1.0f / sqrtf(ssq * (1.0f / 384) + EPS), rkv = 1.0f / sqrtf(sskv * (1.0f / 256) + EPS);
        { const f32x4 g = *(const f32x4*)(qg + 4 * lane); const f32x4 h = (v0 * rq) * g; u32x2 w; w.x = pk2(h[0], h[1]); w.y = pk2(h[2], h[3]); *(u32x2*)(QL + (size_t)row * 384 + 4 * lane) = w; }
        if (lane < 32) { const f32x4 g = *(const f32x4*)(qg + 256 + 4 * lane); const f32x4 h = (v1 * rq) * g; u32x2 w; w.x = pk2(h[0], h[1]); w.y = pk2(h[2], h[3]); *(u32x2*)(QL + (size_t)row * 384 + 256 + 4 * lane) = w; }
        else { const f32x4 g = *(const f32x4*)(kvg + 4 * (lane - 32)); const f32x4 h = (v1 * rkv) * g; u32x2 w; w.x = pk2(h[0], h[1]); w.y = pk2(h[2], h[3]); *(u32x2*)(KVL + (size_t)row * 256 + 4 * (lane - 32)) = w; }
        if (lane < 32) { const f32x4 g = *(const f32x4*)(kvg + 128 + 4 * lane); const f32x4 h = (v2 * rkv) * g; u32x2 w; w.x = pk2(h[0], h[1]); w.y = pk2(h[2], h[3]); *(u32x2*)(KVL + (size_t)row * 256 + 128 + 4 * lane) = w; }
        f32x4 pr; pr[0] = __shfl_xor(v2[0], 2); pr[1] = __shfl_xor(v2[1], 2); pr[2] = __shfl_xor(v2[2], 2); pr[3] = __shfl_xor(v2[3], 2);
        if (lane >= 32 && lane < 40) {
            const int q = lane - 32; f32x4 h = v2;
            if (row < RL) {
                const int t = row & (SEQ - 1), pos = (q < 4) ? (t >> 6) : (t & 63);
                const float* tp = tabc + (size_t)(pos * 8 + 4 * (q & 1)) * 2;
                const f32x4 cs01 = *(const f32x4*)tp, cs23 = *(const f32x4*)(tp + 4);
                const f32x4 cs = {cs01[0], cs01[2], cs23[0], cs23[2]}, sn = {cs01[1], cs01[3], cs23[1], cs23[3]};
                const f32x4 sg = (q & 2) ? sn : -sn;
                h = v2 * cs + pr * sg;
            }
            u32x2 w; w.x = pk2(h[0], h[1]); w.y = pk2(h[2], h[3]); *(u32x2*)(KR + (size_t)row * 32 + 4 * q + ((q >> 1) == 1 ? 8 : ((q >> 1) == 2 ? -8 : 0))) = w;
        }
    }
}

DI void transpose_item(const float* W, int N, int k0, int n0, bf16_t* WT, int ldt, int orow0, LAS float* scr, int lane, bool perm = false) {
#pragma unroll 8
    for (int i = 0; i < 32; ++i) { const int kk = 2 * i + (lane >> 5); scr[kk * 33 + (lane & 31)] = W[(size_t)(k0 + kk) * N + n0 + (lane & 31)]; }
    asm volatile("s_waitcnt lgkmcnt(0)" ::: "memory");
    const int c = lane & 7;
#pragma unroll
    for (int j = 0; j < 4; ++j) { const int n = (lane >> 3) + 8 * j; const LAS float* s = scr + (8 * c) * 33 + n;
        u32x4 o; o.x = pk2(s[0 * 33], s[1 * 33]); o.y = pk2(s[2 * 33], s[3 * 33]); o.z = pk2(s[4 * 33], s[5 * 33]); o.w = pk2(s[6 * 33], s[7 * 33]);
        const int np = perm ? (((n >> 3) == 1) ? n + 8 : (((n >> 3) == 2) ? n - 8 : n)) : n;
        *(u32x4*)(WT + (size_t)(orow0 + np) * ldt + k0 + 8 * c) = o; }
    asm volatile("s_waitcnt lgkmcnt(0)" ::: "memory");
}
DI void sincos_acc(float ang, float& c, float& s) {
    const double a = (double)ang, twopi = 6.283185307179586476925287;
    const double k = __builtin_rint(a / twopi); const double r = a - k * twopi;
    const double r2 = r * r; double ts = r, tc = 1.0, ss = r, cc = 1.0;
#pragma unroll
    for (int i = 1; i <= 13; ++i) { tc = -tc * r2 / (double)((2 * i - 1) * (2 * i)); cc += tc; ts = -ts * r2 / (double)((2 * i) * (2 * i + 1)); ss += ts; }
    c = (float)cc; s = (float)ss;
}
__device__ const float INVF_AB[16] = {1.000000000e+00f, 5.623413324e-01f, 3.162277639e-01f, 1.778279394e-01f, 1.000000015e-01f, 5.623413250e-02f, 3.162277490e-02f, 1.778279431e-02f,
                                      9.999999776e-03f, 5.623413250e-03f, 3.162277630e-03f, 1.778279431e-03f, 1.000000047e-03f, 5.623413017e-04f, 3.162277571e-04f, 1.778279402e-04f};
__device__ const float INVF_C[8] = {1.000000000e+00f, 3.162277639e-01f, 1.000000015e-01f, 3.162277490e-02f, 9.999999776e-03f, 3.162277630e-03f, 1.000000047e-03f, 3.162277571e-04f};

struct Args { const float* in[20]; float* out; unsigned char* ws; int ph_lo, ph_hi; };

DI void prologue_phase(const Args& A, LAS unsigned char* lds) {
    int tid_ = threadIdx.x; asm volatile("" : "+v"(tid_));
    int bx_ = blockIdx.x; asm volatile("" : "+s"(bx_));
    const int tid = tid_, lane = tid & 63, wave = tid >> 6, G = gridDim.x, bx = bx_;
    unsigned char* ws = A.ws;
    {
        LAS float* sv = (LAS float*)lds;
        LAS float* red = (LAS float*)(lds + 16384);
        bool did = false;
        for (int item = bx; item < 192; item += G) {
            if (!did) {
                for (int i = tid; i < 3072; i += NTHR) { const float v = i < 2048 ? A.in[1][i] : A.in[3][i - 2048]; sv[i] = v / (1.0f + __expf(-v)); }
                __syncthreads(); did = true;
            }
            const int l = item / 96, n0 = (item % 96) * 64, c = lane, ks = wave;
            const float* W = A.in[4] + (size_t)l * 1024 * 6144 + n0 + c;
            float a0 = 0.f, a1 = 0.f, a2 = 0.f;
#pragma unroll 8
            for (int k = ks * 128; k < ks * 128 + 128; ++k) { const float w = W[(size_t)k * 6144]; a0 += sv[k] * w; a1 += sv[1024 + k] * w; a2 += sv[2048 + k] * w; }
            red[(ks * 3 + 0) * 64 + c] = a0; red[(ks * 3 + 1) * 64 + c] = a1; red[(ks * 3 + 2) * 64 + c] = a2;
            __syncthreads();
            if (tid < 192) { const int g = tid >> 6, cc = tid & 63; float s = A.in[5][l * 6144 + n0 + cc];
#pragma unroll
                for (int k8 = 0; k8 < 8; ++k8) s += red[(k8 * 3 + g) * 64 + cc];
                ((float*)(ws + OFF_MOD))[(size_t)(l * 3 + g) * 6144 + n0 + cc] = s; }
            __syncthreads();
        }
        __syncthreads();
    }
    if (bx == G - 1) {
        float* tab = (float*)(ws + OFF_TAB_AB); float* tabc = (float*)(ws + OFF_TAB_C);
        for (int e = tid; e < 2048; e += NTHR) { const int pos = e >> 4, i = e & 15; float c, s; sincos_acc((float)pos * INVF_AB[i], c, s); tab[2 * e] = c; tab[2 * e + 1] = s; }
        for (int e = tid; e < 1024; e += NTHR) { const int pos = e >> 3, i = e & 7; float c, s; sincos_acc((float)pos * INVF_C[i], c, s); tabc[2 * e] = c; tabc[2 * e + 1] = s; }
    }
    { u32x4* z = (u32x4*)(ws + W_MIN + (size_t)672 * 1024 * 2); const u32x4 zero = {0u, 0u, 0u, 0u};
      for (int i = bx * NTHR + tid; i < 96 * 1024 * 2 / 16; i += G * NTHR) z[i] = zero; }
    {
        LAS float* scr = (LAS float*)(lds + wave * 16384);
        const int gw = bx * NWAVES + wave, ngw = G * NWAVES;
        constexpr int I1 = 16 * 72, I2 = 16 * 32, I3 = 16 * 176, I4 = 44 * 32, I5 = 16 * 21, I6 = 6 * 48, I7 = 4 * 64, I8 = 16 * 32;
        constexpr int NITEMS = I1 + I2 + 2 * I3 + 2 * I4 + I5 + I6 + I7 + I8;
        for (int it = gw; it < NITEMS; it += ngw) {
            int r = it;
            if (r < I1) { const int kb = r / 72, nb = r % 72; transpose_item(A.in[9], 2304, 64 * kb, 32 * nb, (bf16_t*)(ws + W_ABIN), 1024, 32 * nb, scr, lane); continue; } r -= I1;
            if (r < I2) { const int kb = r / 32, nb = r % 32; transpose_item(A.in[10], 1024, 64 * kb, 32 * nb, (bf16_t*)(ws + W_ABOUT), 1024, 32 * nb, scr, lane); continue; } r -= I2;
            if (r < 2 * I3) { const int l = r / I3, q = r % I3, kb = q / 176, nb = q % 176, n0 = 32 * nb, half = n0 / FH, rem = n0 % FH;
                transpose_item(A.in[7] + (size_t)l * 1024 * 5632, 5632, 64 * kb, n0, (bf16_t*)(ws + W_13) + (size_t)l * 5632 * 1024, 1024, 256 * (rem / 128) + 128 * half + (rem % 128), scr, lane); continue; } r -= 2 * I3;
            if (r < 2 * I4) { const int l = r / I4, q = r % I4, kb = q / 32, nb = q % 32;
                transpose_item(A.in[8] + (size_t)l * FH * 1024, 1024, 64 * kb, 32 * nb, (bf16_t*)(ws + W_2) + (size_t)l * 1024 * FH, FH, 32 * nb, scr, lane); continue; } r -= 2 * I4;
            if (r < I5) { const int kb = r / 21, nb = r % 21; transpose_item(A.in[14], 672, 64 * kb, 32 * nb, (bf16_t*)(ws + W_MIN), 1024, 32 * nb, scr, lane); continue; } r -= I5;
            if (r < I6) { const int kb = r / 48, nb = r % 48; transpose_item(A.in[17], 1536, 64 * kb, 32 * nb, (bf16_t*)(ws + W_QB), 384, 32 * nb, scr, lane, (nb % 3) == 2); continue; } r -= I6;
            if (r < I7) { const int kb = r / 64, nb = r % 64; transpose_item(A.in[18], 2048, 64 * kb, 32 * nb, (bf16_t*)(ws + W_KVB), 256, 32 * nb, scr, lane); continue; } r -= I7;
            { const int kb = r / 32, nb = r % 32; transpose_item(A.in[19], 1024, 64 * kb, 32 * nb, (bf16_t*)(ws + W_MOUT), 1024, 32 * nb, scr, lane); }
        }
    }
}

DI void attn_layer0_phase(const Args& A, char* lds) {
    int tid_ = threadIdx.x; asm volatile("" : "+v"(tid_));
    int bx_ = blockIdx.x; asm volatile("" : "+s"(bx_));
    unsigned char* ws = A.ws; const int G = gridDim.x, bx = bx_, lane = tid_ & 63;
    const bf16_t* PQ = (const bf16_t*)(ws + OFF_BIG); bf16_t* OA = (bf16_t*)(ws + OFF_HXR); float* OD = (float*)(ws + OFF_YR);
    const float* lv = A.in[12];
    const float lam = __expf(wave_sum(lv[lane] * lv[64 + lane])) - __expf(wave_sum(lv[128 + lane] * lv[192 + lane])) + 0.2f;
    const float* subg = A.in[13];
#ifndef NO_B
    for (int pu = bx; pu < 256 + 8; pu += G) {
        int b, hb, qrow0, ctxq;
        if (pu < 256) { const int x = pu & 7; b = x >> 2; hb = x & 3; qrow0 = b * SEQ + (pu >> 3) * 256; ctxq = 0; }
        else { const int x = pu - 256; b = x >> 2; hb = x & 3; qrow0 = RL + b * CTXL; ctxq = 1; }
#pragma unroll 1
        for (int mh = 0; mh < 2; ++mh) {
            att::Job J;
            J.Q = PQ + (size_t)qrow0 * ABW + 512 + hb * 128 + mh * 64; J.ldq = ABW;
            J.K1 = PQ + 1280 + hb * 128 + mh * 64; J.ldk1 = ABW; J.K2 = PQ; J.ldk2 = ABW;
            J.V = PQ + 1792 + hb * 128; J.ldv = ABW;
            if (ctxq) { J.row1 = RL + b * CTXL; J.nt1 = 4; J.row2 = 0; J.nt2 = 0; }
            else { J.row1 = b * SEQ; J.nt1 = SEQ / 64; J.row2 = RL + b * CTXL; J.nt2 = 4; }
            J.win = 0; J.qpos0 = 0; J.kpos0 = 0; J.m0 = att::NEGBIG; J.l0 = 0.f;
            J.omode = mh ? 2 : 1;
            J.Ob = OA + (size_t)qrow0 * DM + 512 + hb * 128; J.ldo = DM;
            J.Of = OD + (size_t)qrow0 * 512 + hb * 128; J.ldf = 512;
            J.lam = lam; J.subg = subg;
            att::unit<0, 128>(J, lds);
        }
    }
#endif
#ifndef NO_A
    for (int u = bx; u < 512 + 16; u += G) {
        att::Job J; int b, h, qrow0;
        if (u < 512) {
            const int qb = u & 31; h = (u >> 5) & 7; b = u >> 8; qrow0 = b * SEQ + qb * 256;
            const int k0 = qb * 256 - 128 < 0 ? 0 : qb * 256 - 128, k1 = qb * 256 + 384 > SEQ ? SEQ : qb * 256 + 384;
            J.row1 = b * SEQ + k0; J.nt1 = (k1 - k0) / 64; J.row2 = RL + b * CTXL; J.nt2 = 4; J.win = 1; J.qpos0 = qb * 256; J.kpos0 = k0;
        } else {
            const int x = u - 512; b = x >> 3; h = x & 7; qrow0 = RL + b * CTXL;
            J.row1 = RL + b * CTXL; J.nt1 = 4; J.row2 = 0; J.nt2 = 0; J.win = 0; J.qpos0 = 0; J.kpos0 = 0;
        }
        J.Q = PQ + (size_t)qrow0 * ABW + h * 64; J.ldq = ABW;
        J.K1 = PQ + 1024 + (h >> 2) * 64; J.ldk1 = ABW; J.K2 = PQ; J.ldk2 = ABW;
        J.V = PQ + 1152 + (h >> 2) * 64; J.ldv = ABW;
        J.m0 = A.in[11][h] * LOG2E; J.l0 = 1.f; J.omode = 0;
        J.Ob = OA + (size_t)qrow0 * DM + h * 64; J.ldo = DM; J.Of = OD; J.ldf = 512; J.lam = 0.f; J.subg = subg;
        att::unit<0, 64>(J, lds);
    }
#endif
}
DI void attn_mla_phase(const Args& A, char* lds) {
    int bx_ = blockIdx.x; asm volatile("" : "+s"(bx_));
    unsigned char* ws = A.ws; const int G = gridDim.x, bx = bx_;
    const bf16_t* Q1 = (const bf16_t*)(ws + OFF_YR); const bf16_t* KV = (const bf16_t*)(ws + OFF_BIG); const bf16_t* KR = (const bf16_t*)(ws + OFF_KR);
    bf16_t* OA = (bf16_t*)(ws + OFF_HXR);
    for (int u = bx; u < 1024; u += G) {
        const int i = u >> 8, cc = u & 255, bh = i * 8 + (cc & 7), qb = cc >> 3, b = bh >> 4, h = bh & 15, qrow0 = b * SEQ + qb * 256;
        att::Job J;
        J.Q = Q1 + (size_t)qrow0 * 1536 + h * 96; J.ldq = 1536;
        J.K1 = KV + h * 128; J.ldk1 = 2048; J.K2 = KR; J.ldk2 = 32; J.V = KV + h * 128 + 64; J.ldv = 2048;
        J.row1 = b * SEQ; J.nt1 = SEQ / 64; J.row2 = RL + b * CTXL; J.nt2 = 4; J.win = 0; J.qpos0 = 0; J.kpos0 = 0;
        J.m0 = att::NEGBIG; J.l0 = 0.f; J.omode = 0;
        J.Ob = OA + (size_t)qrow0 * DM + h * 64; J.ldo = DM; J.Of = nullptr; J.ldf = 0; J.lam = 0.f; J.subg = nullptr;
        att::unit<32, 64>(J, lds);
    }
}

DI int fresh_bx() { int b = blockIdx.x; asm volatile("" : "+s"(b)); return b; }
constexpr int N_PHASES = 18;
typedef const __attribute__((address_space(4))) Args* KArgsP;
DI Args load_args() {
#if defined(__HIP_DEVICE_COMPILE__)
    KArgsP p = (KArgsP)__builtin_amdgcn_kernarg_segment_ptr(); asm volatile("" : "+s"(p)); return *p;
#else
    return Args{};
#endif
}
DI bool phase_in(int k) {
#if defined(__HIP_DEVICE_COMPILE__)
    KArgsP p = (KArgsP)__builtin_amdgcn_kernarg_segment_ptr(); asm volatile("" : "+s"(p)); return p->ph_lo <= k && k < p->ph_hi;
#else
    return false;
#endif
}
__global__ void __launch_bounds__(NTHR, 2) dit_fwd(Args A_) {
    extern __shared__ __attribute__((aligned(16))) unsigned char lds_raw[];
    LAS unsigned char* lds = (LAS unsigned char*)lds_raw;
#ifndef DISMASK
#define DISMASK 0
#endif
#define EN(n) (!((DISMASK >> (n)) & 1))
#ifndef REPMASK
#define REPMASK 0
#endif
#define REP(n) _Pragma("unroll 1") for (int rep_ = 0; rep_ < ((((REPMASK) >> (n)) & 1) ? 2 : 1); ++rep_)
#define IN(k) phase_in(k)
    if (threadIdx.x < 2) ((volatile LAS unsigned*)(lds + LDS_ST_OFF))[threadIdx.x] = 0u;
    __syncthreads();
    if (phase_in(0) && phase_in(1)) { const Args Ab = load_args(); (void)xcd_barrier_post((unsigned*)(Ab.ws + OFF_BAR), (volatile LAS unsigned*)(lds + LDS_ST_OFF)); }
    if (phase_in(-7)) cg::this_grid().sync();
#define SEAM(k) do { if (IN(k) && IN((k) + 1)) { const Args Ab = load_args(); XcdBarrier bar_; bar_.bar = (unsigned*)(Ab.ws + OFF_BAR); bar_.x = xb_xcc_id(); bar_.st = (volatile LAS unsigned*)(lds + LDS_ST_OFF); xcd_barrier(bar_); } } while (0)
#define FRESH() const Args A = load_args(); unsigned char* ws = A.ws; (void)ws; int tid_ = threadIdx.x; asm volatile("" : "+v"(tid_)); \
    const int lane = tid_ & 63, ngw = (int)gridDim.x * NWAVES, gw = fresh_bx() * NWAVES + __builtin_amdgcn_readfirstlane(tid_ >> 6); (void)lane; (void)gw; (void)ngw; \
    float* mod = (float*)(ws + OFF_MOD); bf16_t* HX = (bf16_t*)(ws + OFF_HXR); float* Y = (float*)(ws + OFF_YR); float* XSC = (float*)(ws + OFF_XSC); const float* normg = A.in[6]; \
    (void)mod; (void)HX; (void)Y; (void)XSC; (void)normg

    if (IN(0) && EN(0)) REP(0) { FRESH(); prologue_phase(A, lds); } SEAM(0);
    if (IN(1) && EN(1)) REP(1) {
        FRESH(); RowOp P{A.in[0], A.in[2], nullptr, nullptr, nullptr, nullptr, nullptr, normg, mod + 0 * 1024, mod + 1 * 1024, HX, RT, nullptr, 0};
        rowop_phase(P, gw, ngw, lane);
    } SEAM(1);
#pragma unroll 1
    for (int l = 0; l < 2; ++l) {
        const int pb = l == 0 ? 4 : 13;
        if (l == 0) {
            if (IN(2) && EN(2)) REP(2) { FRESH(); EpiQKV E{(bf16_t*)(ws + OFF_BIG), (const float*)(ws + OFF_TAB_AB)}; run_gemm(lds, HX, DM, (const bf16_t*)(ws + W_ABIN), RT, ABW, DM, E); } SEAM(2);
            if (IN(3) && EN(3)) REP(3) { FRESH(); attn_layer0_phase(A, (char*)lds_raw); } SEAM(3);
        } else {
            if (IN(9) && EN(9)) REP(9) { FRESH(); EpiF32 E{(float*)(ws + OFF_BIG), 768}; run_gemm(lds, HX, DM, (const bf16_t*)(ws + W_MIN), RT, 768, DM, E); } SEAM(9);
            if (IN(10) && EN(10)) REP(10) { FRESH(); mla_prep_phase((const float*)(ws + OFF_BIG), A.in[15], A.in[16], (const float*)(ws + OFF_TAB_C), (bf16_t*)(ws + OFF_QL), (bf16_t*)(ws + OFF_KVL), (bf16_t*)(ws + OFF_KR), gw, ngw, lane); } SEAM(10);
            if (IN(11) && EN(11)) REP(11) {
                { FRESH(); EpiMlaQ E{(bf16_t*)(ws + OFF_YR), (const float*)(ws + OFF_TAB_C)}; run_gemm(lds, (const bf16_t*)(ws + OFF_QL), 384, (const bf16_t*)(ws + W_QB), RL, 1536, 384, E); }
                { FRESH(); EpiBf16P E{(bf16_t*)(ws + OFF_BIG), 2048}; run_gemm(lds, (const bf16_t*)(ws + OFF_KVL), 256, (const bf16_t*)(ws + W_KVB), RT, 2048, 256, E); }
            } SEAM(11);
            if (IN(12) && EN(12)) REP(12) { FRESH(); attn_mla_phase(A, (char*)lds_raw); } SEAM(12);
        }
        const int M_l = l == 0 ? RT : RL;
        if (IN(pb) && EN(4)) REP(4) { FRESH(); EpiF32 E{Y, DM}; run_gemm(lds, HX  , DM, (const bf16_t*)(ws + (l == 0 ? W_ABOUT : W_MOUT)), RL, DM, DM, E);
            if (l == 0) run_gemm_splitk(lds, HX + (size_t)RL * DM, DM, (const bf16_t*)(ws + W_ABOUT), DM, RT - RL, DM, 256, 4, (float*)(ws + OFF_TAIL), nullptr, 4); } SEAM(pb);
        if (IN(pb + 1) && EN(5)) REP(5) {
            FRESH(); const float* modl = mod + (size_t)l * 3 * 6144;
            RowOp P{l == 0 ? A.in[0] : A.out, l == 0 ? A.in[2] : XSC, Y, normg + (l * 4 + 1) * DM, modl + 2 * 1024, A.out, XSC,
                    normg + (l * 4 + 2) * DM, modl + 3 * 1024, modl + 4 * 1024, HX, M_l, (const float*)(ws + OFF_TAIL), l == 0 ? 4 : 0};
            rowop_phase(P, gw, ngw, lane);
        } SEAM(pb + 1);
        if (IN(pb + 2) && EN(6)) REP(6) { FRESH(); EpiSwiGLU E{(bf16_t*)(ws + OFF_BIG), FH}; run_gemm(lds, HX, DM, (const bf16_t*)(ws + W_13) + (size_t)l * 5632 * 1024, M_l, 5632, DM, E); } SEAM(pb + 2);
        if (IN(pb + 3) && EN(7)) REP(7) { FRESH(); EpiF32 E{Y, DM}; run_gemm(lds, (const bf16_t*)(ws + OFF_BIG), FH, (const bf16_t*)(ws + W_2) + (size_t)l * 1024 * FH, RL, DM, FH, E);
            if (l == 0) run_gemm_splitk(lds, (const bf16_t*)(ws + OFF_BIG) + (size_t)RL * FH, FH, (const bf16_t*)(ws + W_2), FH, RT - RL, DM, 1408, 2, (float*)(ws + OFF_TAIL), nullptr, 2); } SEAM(pb + 3);
        if (IN(pb + 4) && EN(8)) REP(8) {
            FRESH(); const float* modl = mod + (size_t)l * 3 * 6144; const float* mod1 = mod + (size_t)3 * 6144;
            RowOp P{A.out, XSC, Y, normg + (l * 4 + 3) * DM, modl + 5 * 1024, A.out, l == 0 ? XSC : nullptr,
                    normg + 4 * DM, mod1 + 0 * 1024, mod1 + 1 * 1024, l == 0 ? HX : nullptr, M_l, (const float*)(ws + OFF_TAIL), l == 0 ? 2 : 0};
            rowop_phase(P, gw, ngw, lane);
        }
        if (l == 0) SEAM(8);
    }
#undef IN
#undef SEAM
#undef FRESH
}

extern "C" void kernel_launch(void* const* d_in, const int* in_sizes, int n_in, void* d_out, int out_size, void* d_ws, size_t ws_size, hipStream_t stream) {
    static int grid = 0;
    if (grid == 0) {
        if (n_in != 20 || in_sizes[0] != RL * DM || out_size != RL * DM || ws_size < WS_END) { fprintf(stderr, "kernel_launch: unexpected shapes (n_in %d, in0 %d, out %d, ws %zu)\n", n_in, n_in > 0 ? in_sizes[0] : -1, out_size, ws_size); grid = -1; return; }
        int dev = 0, cus = 0, per_cu = 0;
        if (hipGetDevice(&dev) != hipSuccess || hipDeviceGetAttribute(&cus, hipDeviceAttributeMultiprocessorCount, dev) != hipSuccess) { grid = -1; return; }
        if (hipFuncSetAttribute((const void*)dit_fwd, hipFuncAttributeMaxDynamicSharedMemorySize, LDS_BYTES) != hipSuccess) { fprintf(stderr, "kernel_launch: hipFuncSetAttribute failed\n"); grid = -1; return; }
        if (hipOccupancyMaxActiveBlocksPerMultiprocessor(&per_cu, (const void*)dit_fwd, NTHR, LDS_BYTES) != hipSuccess || per_cu < 1) { fprintf(stderr, "kernel_launch: occupancy query says %d\n", per_cu); per_cu = 1; }
        (void)hipGetLastError();
        grid = cus * per_cu;
    }
    if (grid < 0) return;
    Args a{};
    for (int i = 0; i < 20; ++i) a.in[i] = (const float*)d_in[i];
    a.out = (float*)d_out; a.ws = (unsigned char*)d_ws;
#if MK_PER_PHASE
    for (int p = 0; p < N_PHASES; ++p) { a.ph_lo = p; a.ph_hi = p + 1; hipLaunchKernelGGL(dit_fwd, dim3(grid), dim3(NTHR), LDS_BYTES, stream, a); }
#else
    a.ph_lo = 0; a.ph_hi = N_PHASES;
    if (hipMemsetAsync((char*)d_ws + OFF_BAR, 0, XCD_BAR_WORDS * sizeof(unsigned), stream) != hipSuccess) { fprintf(stderr, "kernel_launch: memset of the barrier words failed\n"); return; }
    void* args[] = {&a};
    hipError_t e = hipLaunchCooperativeKernel((const void*)dit_fwd, dim3(grid), dim3(NTHR), args, LDS_BYTES, stream);
    if (e != hipSuccess) fprintf(stderr, "cooperative launch failed: %s (grid %d)\n", hipGetErrorString(e), grid);
#endif
}
```
